# Optimizing an MI355X kernel written in HIP

```python
import jax, jax.numpy as jnp
from jax import lax
import numpy as np

D_MODEL = 1024
BATCH = 2
SEQ = 8192
DEPTH = 2
DEC_BATCH = 16
DEC_SEQ = 4096
PAST_LEN = 128

A_HEADS = 8
A_HEAD_DIM = 128
A_WIDTH = A_HEADS * A_HEAD_DIM
B_WIDTH = D_MODEL
CONV_WIDTH = 3
CHUNK = 64
EPS = 1e-6
F_MIN = 1e-20
SPLIT_WIDTHS = (A_WIDTH, A_WIDTH, A_WIDTH, A_WIDTH, A_WIDTH, B_WIDTH, B_WIDTH, B_WIDTH, B_WIDTH, D_MODEL, D_MODEL)
PROJ_WIDTH = sum(SPLIT_WIDTHS)
SPLIT_POINTS = tuple(sum(SPLIT_WIDTHS[:j + 1]) for j in range(len(SPLIT_WIDTHS) - 1))

kernel_name = "hgrn2_shortconv_gated_hybrid_encoder"


def _rmsnorm(x, g):
    xf = x.astype(jnp.float32)
    y = xf * lax.rsqrt(jnp.mean(xf * xf, axis=-1, keepdims=True) + EPS)
    return (y * g.astype(jnp.float32)).astype(x.dtype)


def _lower_bounds(raw):
    p = jax.nn.softmax(raw.astype(jnp.float32), axis=0)
    return jnp.cumsum(p, axis=0) - p[0:1]


def _forget(f_raw, lb):
    f_raw = f_raw.astype(jnp.float32)
    f = lb + (1.0 - lb) * jax.nn.sigmoid(f_raw)
    logf = jnp.log(jnp.maximum(f, F_MIN))
    one_minus_f = (1.0 - lb) * jax.nn.sigmoid(-f_raw)
    return logf, one_minus_f


def _to_heads(a):
    b, L, _ = a.shape
    return a.reshape(b, L, A_HEADS, A_HEAD_DIM).transpose(0, 2, 1, 3).astype(jnp.float32)


def _gla_chunk_scan(q, k, v, logf):
    b, h, L, dk = q.shape
    dv = v.shape[-1]
    n = L // CHUNK

    def to_chunks(a):
        return jnp.moveaxis(a.reshape(b, h, n, CHUNK, a.shape[-1]), 2, 0)

    qc, kc, vc, gc = to_chunks(q), to_chunks(k), to_chunks(v), to_chunks(logf)
    mask = jnp.tril(jnp.ones((CHUNK, CHUNK), dtype=bool))[:, :, None]

    def step(S, inp):
        q_, k_, v_, g_ = inp
        G = jnp.cumsum(g_, axis=2)
        diff = G[:, :, :, None, :] - G[:, :, None, :, :]
        decay = jnp.where(mask, jnp.exp(jnp.minimum(diff, 0.0)), 0.0)
        scores = jnp.einsum('bhtsk,bhsk->bhts', q_[:, :, :, None, :] * decay, k_)
        o = (jnp.einsum('bhts,bhsv->bhtv', scores, v_)
             + jnp.einsum('bhtk,bhkv->bhtv', q_ * jnp.exp(G), S))
        G_last = G[:, :, -1:, :]
        k_dec = k_ * jnp.exp(G_last - G)
        S = S * jnp.exp(G_last[:, :, 0, :])[..., None] + jnp.einsum('bhsk,bhsv->bhkv', k_dec, v_)
        return S, o

    S0 = jnp.zeros((b, h, dk, dv), jnp.float32)
    _, o = lax.scan(step, S0, (qc, kc, vc, gc))
    return jnp.moveaxis(o, 0, 2).reshape(b, h, L, dv)


def _hgrn2_bidir(q, i, f_fw, f_bw, lb_fw, lb_bw, hnorm_g):
    b, L, _ = q.shape
    qh = _to_heads(q) * (A_HEAD_DIM ** -0.5)
    vh = _to_heads(i)

    def one_direction(f_raw, lb, reverse):
        logf, one_minus_f = _forget(f_raw, lb)
        logf = _to_heads(logf)
        kh = _to_heads(one_minus_f)
        if reverse:
            flip = lambda a: jnp.flip(a, axis=2)
            return flip(_gla_chunk_scan(flip(qh), flip(kh), flip(vh), flip(logf)))
        return _gla_chunk_scan(qh, kh, vh, logf)

    o = one_direction(f_fw, lb_fw, False) + one_direction(f_bw, lb_bw, True)
    o = o * lax.rsqrt(jnp.mean(o * o, axis=-1, keepdims=True) + EPS)
    o = o * hnorm_g.astype(jnp.float32).reshape(A_HEADS, 1, A_HEAD_DIM)
    return o.transpose(0, 2, 1, 3).reshape(b, L, A_WIDTH)


def _centred_short_conv(u, w, bias):
    up = jnp.pad(u, ((0, 0), (1, 1), (0, 0)))
    return up[:, :-2] * w[0] + up[:, 1:-1] * w[1] + up[:, 2:] * w[2] + bias


def _layer(x, norm_g, w_in, lb_fw, lb_bw, hnorm_g, conv_w, conv_b, w_a, w_b, w_o):
    h = _rmsnorm(x, norm_g)
    proj = jnp.einsum('bld,de->ble', h, w_in)
    (q, f_fw, f_bw, i, z_a, c_B, c_C, c_x, z_b, g_a, g_b) = jnp.split(proj, SPLIT_POINTS, axis=-1)
    o_a = _hgrn2_bidir(q, i, f_fw, f_bw, lb_fw, lb_bw, hnorm_g).astype(x.dtype)
    p_a = jnp.einsum('ble,ed->bld', o_a * jax.nn.silu(z_a), w_a)
    conv = _centred_short_conv(c_C * c_x, conv_w, conv_b)
    p_b = jnp.einsum('ble,ed->bld', c_B * conv * jax.nn.silu(z_b), w_b)
    merged = jax.nn.sigmoid(g_a) * p_a + jax.nn.sigmoid(g_b) * p_b
    return x + jnp.einsum('bld,de->ble', merged, w_o)


def _trunk(x, norm_g, w_in, lb_fw_all, lb_bw_all, hnorm_g, conv_w, conv_b, w_a, w_b, w_o, final_g):
    for l in range(DEPTH):
        x = _layer(x, norm_g[l], w_in[l], lb_fw_all[l], lb_bw_all[l], hnorm_g[l],
                   conv_w[l], conv_b[l], w_a[l], w_b[l], w_o[l])
    return _rmsnorm(x, final_g)


def setup_inputs(seed: int = 0) -> dict:
    key = jax.random.key(seed)
    ks = jax.random.split(key, 14)
    f32 = jnp.float32
    nrm = jax.random.normal
    return {
        "x_prompt": nrm(ks[0], (BATCH, SEQ, D_MODEL), f32),
        "x_sample": nrm(ks[1], (DEC_BATCH, DEC_SEQ, D_MODEL), f32),
        "norm_g": 1.0 + 0.05 * nrm(ks[2], (DEPTH, D_MODEL), f32),
        "w_in": nrm(ks[3], (DEPTH, D_MODEL, PROJ_WIDTH), f32) * (D_MODEL ** -0.5),
        "lb_fwd": 1.0 + 0.1 * nrm(ks[4], (DEPTH, A_WIDTH), f32),
        "lb_bwd": 1.0 + 0.1 * nrm(ks[5], (DEPTH, A_WIDTH), f32),
        "hnorm_g": 1.0 + 0.05 * nrm(ks[6], (DEPTH, A_WIDTH), f32),
        "conv_w": nrm(ks[7], (DEPTH, CONV_WIDTH, B_WIDTH), f32) * (CONV_WIDTH ** -0.5),
        "conv_b": 0.02 * nrm(ks[8], (DEPTH, B_WIDTH), f32),
        "w_a": nrm(ks[9], (DEPTH, A_WIDTH, D_MODEL), f32) * (A_WIDTH ** -0.5),
        "w_b": nrm(ks[10], (DEPTH, B_WIDTH, D_MODEL), f32) * (B_WIDTH ** -0.5),
        "w_o": nrm(ks[11], (DEPTH, D_MODEL, D_MODEL), f32) * (D_MODEL ** -0.5),
        "final_g": 1.0 + 0.05 * nrm(ks[12], (D_MODEL,), f32),
    }


def reference(x_prompt, x_sample, norm_g, w_in, lb_fwd, lb_bwd, hnorm_g, conv_w, conv_b, w_a, w_b, w_o, final_g):
    lb_fw_all = _lower_bounds(lb_fwd)
    lb_bw_all = _lower_bounds(lb_bwd)
    y_prompt = _trunk(x_prompt, norm_g, w_in, lb_fw_all, lb_bw_all, hnorm_g, conv_w, conv_b, w_a, w_b, w_o, final_g)
    y_sample = _trunk(x_sample, norm_g, w_in, lb_fw_all, lb_bw_all, hnorm_g, conv_w, conv_b, w_a, w_b, w_o, final_g)
    return (y_prompt, y_sample)
```

```cpp
#include <hip/hip_runtime.h>
#include <hip/hip_cooperative_groups.h>
#include <cstdio>
namespace cg = cooperative_groups;

#define LAS __attribute__((address_space(3)))
typedef unsigned short bf16_t;
typedef short bf16x8 __attribute__((ext_vector_type(8)));
typedef float f32x4 __attribute__((ext_vector_type(4)));
typedef float f32x16 __attribute__((ext_vector_type(16)));
typedef unsigned u32x4 __attribute__((ext_vector_type(4)));
typedef unsigned u32x2 __attribute__((ext_vector_type(2)));

constexpr int DM = 1024;
constexpr int NPROJ = 11264;
constexpr int T_PROMPT = 16384;
constexpr int T_ALL = 81920;
constexpr int NPASS = 2;
constexpr int PASS_TOK0 = 0, PASS_TOK1 = 32768;
constexpr int TP_MAX = 49152;
constexpr float EPS = 1e-6f;
constexpr float LOG2E = 1.4426950408889634f;

constexpr size_t AB = (size_t)T_ALL * DM * 2;
constexpr size_t PB = (size_t)TP_MAX * DM * 2;
enum { F_QF = 0, F_QB, F_KF, F_KB, F_I, F_H };
enum { S_SZA = 0, S_U, S_M, S_SGA, S_SGB };
constexpr size_t WS_FULL = 0;
constexpr size_t WS_PASS = 2 * AB;
constexpr size_t WS_WIN = 6 * AB;
constexpr int NP1 = 4096, NP2 = 7168, NWIN = NP1 + NP2;
constexpr size_t WS_WA = WS_WIN + (size_t)NWIN * DM * 2;
constexpr size_t WS_WB = WS_WA + (size_t)DM * DM * 2;
constexpr size_t WS_WO = WS_WB + (size_t)DM * DM * 2;
constexpr size_t WS_ET = WS_WO + (size_t)DM * DM * 2;
constexpr int NCHUNK = T_ALL / 64;
constexpr size_t WS_END = WS_ET + (size_t)2 * NCHUNK * 2 * DM * 2;
static_assert(5 * PB <= 3 * AB, "per-pass arrays must fit the dead scan inputs");

constexpr size_t WS_BAR = WS_END;
constexpr size_t WS_TOTAL = WS_BAR + 3456 * 4;
constexpr int BAR_LDS = 131072;
constexpr int LDS_BYTES = 137216;

struct Params {
    const float* xp; const float* xs; const float* norm_g; const float* w_in; const float* lb_fwd; const float* lb_bwd;
    const float* hnorm_g; const float* conv_w; const float* conv_b; const float* w_a; const float* w_b; const float* w_o; const float* final_g;
    float* out; unsigned char* ws;
};

__device__ __forceinline__ unsigned cvt_pk_bf16(float lo, float hi) { unsigned r; asm volatile("v_cvt_pk_bf16_f32 %0, %1, %2" : "=v"(r) : "v"(lo), "v"(hi)); return r; }
__device__ __forceinline__ float bf_lo(unsigned w) { return __uint_as_float(w << 16); }
__device__ __forceinline__ float bf_hi(unsigned w) { return __uint_as_float(w & 0xffff0000u); }
__device__ __forceinline__ float fsigmoid(float x) { return __builtin_amdgcn_rcpf(1.0f + __builtin_amdgcn_exp2f(-x * LOG2E)); }
__device__ __forceinline__ float wave_sum(float v) {
#pragma unroll
    for (int o = 1; o < 64; o <<= 1) v += __shfl_xor(v, o);
    return v;
}
namespace pg8 {
constexpr int BM = 256, BK = 64, HALF = 128, HTB = HALF * BK * 2, STAGE_BYTES = 8 * HTB, NXCD = 8, WGM = 8;
__device__ __forceinline__ int lds_byte(int r, int c) { const int st = (r >> 4) * 2 + (c >> 5), rr = r & 15, cc = c & 31, ob = rr * 64 + cc * 2; return st * 1024 + (ob ^ (((ob >> 9) & 1) << 5)); }
__device__ __forceinline__ void stage_rc(int b, int& R, int& C) { const int st = b / 1024, sb = b % 1024, swz = sb ^ (((sb >> 9) & 1) << 5); R = (st >> 1) * 16 + swz / 64; C = (st & 1) * 32 + (swz % 64) / 2; }
__device__ __forceinline__ int perm32(int rho) { const int n = rho >> 4, i = rho & 15; return 8 * (i >> 2) + 4 * n + (i & 3); }

struct Unit { int pm, pn, kh; };
struct Gemm { const bf16_t* A; const bf16_t* Bt; const bf16_t* A2; const bf16_t* Bt2; int M, N, K; };

struct StaticOrder {
    int nM, nN, nwg, G, c;
    __device__ void init(int M, int N, int G_, int c_) { nM = M / BM; nN = N / BM; nwg = nM * nN; G = G_; c = c_; }
    __device__ bool next(int i, Unit& u) const {
        const long L = (long)i * G + c; if (L >= nwg) return false;
        int wgid = (int)L; { const int q = nwg / NXCD, r = nwg % NXCD, xcd = wgid % NXCD, off = wgid / NXCD; wgid = (xcd < r ? xcd * (q + 1) : r * (q + 1) + (xcd - r) * q) + off; }
        const int nig = WGM * nN, gid = wgid / nig, fm = gid * WGM, gsz = (nM - fm) < WGM ? (nM - fm) : WGM;
        u.pm = fm + ((wgid % nig) % gsz); u.pn = (wgid % nig) / gsz; u.kh = 0; return true;
    }
};

struct SplitOrder : StaticOrder {
    __device__ bool next(int i, Unit& u) const { const bool ok = StaticOrder::next(i >> 1, u); u.kh = i & 1; return ok; }
};

struct PanelGroupOrder {
    int ngroups, G, c;
    __device__ void init(int M, int G_, int c_) { ngroups = (M / BM) * 4; G = G_; c = c_; }
    __device__ bool next(int i, Unit& u) const {
        const int gi = i >> 2, sub = i & 3;
        int L;
        if (G == 256 && (ngroups & 7) == 0) { const int per = ngroups >> 3, x = c & 7, idx = c >> 3; const int off = idx + 32 * gi; if (off >= per) return false; L = x * per + off; }
        else { L = gi * G + c; if (L >= ngroups) return false; }
        const int j = L & 3;
        u.pm = L >> 2; u.pn = sub == 0 ? 2 * j : (sub == 1 ? 2 * j + 1 : (sub == 2 ? 8 + j : 12 + j)); u.kh = 0; return true;
    }
};

template <class Epi, class Sched>
__device__ __forceinline__ void gemm_phase(LAS unsigned char* lds, const Gemm g, const Sched& S, const Epi& E) {
    int tid_ = threadIdx.x; asm volatile("" : "+v"(tid_));
    const int tid = tid_, wid = __builtin_amdgcn_readfirstlane(tid >> 6), lane = tid & 63, wr = wid >> 2, wc = wid & 3, fr = lane & 15, fq = lane >> 4;
    const int K = g.K, nt = K / BK;
    unsigned voffA[2], voffB[2];
#pragma unroll
    for (int i = 0; i < 2; ++i) { int R, C; stage_rc(tid * 16 + i * 8192, R, C); const int Rb = Epi::PERM ? ((R & ~31) + perm32(R & 31)) : R;
        voffA[i] = (unsigned)(R * K + C) * 2u; voffB[i] = (unsigned)(Rb * K + C) * 2u; }
    const size_t kstep = (size_t)(BK * 2);
    const size_t hstep = (size_t)HALF * K * 2;
    const size_t tstep = 2 * hstep;
    const unsigned ldsw = (unsigned)wid * 1024u;
    const int aoff = lds_byte(wr * 64 + fr, fq * 8), boff = lds_byte(wc * 32 + fr, fq * 8);
#define PG8_SA(b, h) (((b) * 2 + (h)) * HTB)
#define PG8_SB(b, h) ((4 + (b) * 2 + (h)) * HTB)
#define PG8_STAGE(bufoff, gbase, voff) do { _Pragma("unroll") for (int _i = 0; _i < 2; ++_i) \
        __builtin_amdgcn_global_load_lds((const unsigned*)((const char*)(gbase) + (voff)[_i]), (LAS unsigned*)(lds + (bufoff) + ldsw + _i * 8192), 16, 0, 0); } while (0)
#define PG8_LDA(dst, b, h) do { _Pragma("unroll") for (int m = 0; m < 4; ++m) _Pragma("unroll") for (int k = 0; k < 2; ++k) dst[m][k] = *(const LAS bf16x8*)(lds + PG8_SA(b, h) + aoff + m * 2048 + k * 1024); } while (0)
#define PG8_LDB(dst, b, h) do { _Pragma("unroll") for (int n = 0; n < 2; ++n) _Pragma("unroll") for (int k = 0; k < 2; ++k) dst[n][k] = *(const LAS bf16x8*)(lds + PG8_SB(b, h) + boff + n * 2048 + k * 1024); } while (0)
#define PG8_MMA(ai, bj, At, Bt) do { __builtin_amdgcn_s_setprio(1); _Pragma("unroll") for (int m = 0; m < 4; ++m) _Pragma("unroll") for (int n = 0; n < 2; ++n) _Pragma("unroll") for (int k = 0; k < 2; ++k) \
        acc[ai][bj][m][n] = __builtin_amdgcn_mfma_f32_16x16x32_bf16(Bt[n][k], At[m][k], acc[ai][bj][m][n], 0, 0, 0); __builtin_amdgcn_s_setprio(0); } while (0)
#define PG8_WAIT_V(n) asm volatile("s_waitcnt vmcnt(" #n ")" ::: "memory")
#define PG8_WAIT_L(n) asm volatile("s_waitcnt lgkmcnt(" #n ")" ::: "memory")
#define PG8_BAR __builtin_amdgcn_s_barrier()
#define PG8_SCHED __builtin_amdgcn_sched_barrier(0)
    Unit cur, nxt; int ui = 0;
    if (!S.next(0, cur)) return;
    f32x4 acc[2][2][4][2];
#pragma unroll
    for (int a = 0; a < 2; ++a)
#pragma unroll
        for (int b = 0; b < 2; ++b)
#pragma unroll
            for (int m = 0; m < 4; ++m)
#pragma unroll
                for (int n = 0; n < 2; ++n) acc[a][b][m][n] = (f32x4){0.f, 0.f, 0.f, 0.f};
    bf16x8 At[4][2], B0[2][2], B1[2][2];
    const char* cA = (const char*)((Epi::SPLITK && cur.kh) ? g.A2 : g.A) + (size_t)cur.pm * tstep; const char* cB = (const char*)((Epi::SPLITK && cur.kh) ? g.Bt2 : g.Bt) + (size_t)cur.pn * tstep;
    PG8_STAGE(PG8_SB(0, 0), cB, voffB); PG8_STAGE(PG8_SA(0, 0), cA, voffA); PG8_STAGE(PG8_SB(0, 1), cB + hstep, voffB); PG8_STAGE(PG8_SA(0, 1), cA + hstep, voffA);
    if (wr == 1) PG8_BAR;
    PG8_WAIT_V(4); PG8_BAR;
    PG8_STAGE(PG8_SB(1, 0), cB + kstep, voffB); PG8_STAGE(PG8_SA(1, 0), cA + kstep, voffA); PG8_STAGE(PG8_SB(1, 1), cB + hstep + kstep, voffB);
    PG8_WAIT_V(6); PG8_BAR;
    for (;;) {
        const bool has_next = S.next(ui + 1, nxt);
        const char* nA = has_next ? (const char*)((Epi::SPLITK && nxt.kh) ? g.A2 : g.A) + (size_t)nxt.pm * tstep : cA; const char* nB = has_next ? (const char*)((Epi::SPLITK && nxt.kh) ? g.Bt2 : g.Bt) + (size_t)nxt.pn * tstep : cB;
        for (int t = 0; t < nt; t += 2) {
            const bool last = (t == nt - 2);
            const char* a1 = cA + (size_t)(t + 1) * kstep;
            const char* a2 = last ? nA : cA + (size_t)(t + 2) * kstep; const char* b2 = last ? nB : cB + (size_t)(t + 2) * kstep;
            const char* a3 = a2 + kstep; const char* b3 = b2 + kstep;
            PG8_LDB(B0, 0, 0); PG8_SCHED; PG8_LDA(At, 0, 0); PG8_STAGE(PG8_SA(1, 1), a1 + hstep, voffA);
            PG8_WAIT_L(8); PG8_BAR; PG8_WAIT_L(0); PG8_MMA(0, 0, At, B0); PG8_BAR; PG8_SCHED;
            PG8_LDB(B1, 0, 1); PG8_STAGE(PG8_SB(0, 0), b2, voffB);
            PG8_BAR; PG8_WAIT_L(0); PG8_MMA(0, 1, At, B1); PG8_BAR;
            PG8_LDA(At, 0, 1); PG8_STAGE(PG8_SA(0, 0), a2, voffA);
            PG8_BAR; PG8_WAIT_L(0); PG8_MMA(1, 0, At, B0); PG8_BAR; PG8_SCHED;
            PG8_STAGE(PG8_SB(0, 1), b2 + hstep, voffB);
            PG8_WAIT_V(6); PG8_BAR; PG8_MMA(1, 1, At, B1); PG8_BAR;
            PG8_LDB(B0, 1, 0); PG8_SCHED; PG8_LDA(At, 1, 0); PG8_STAGE(PG8_SA(0, 1), a2 + hstep, voffA);
            PG8_WAIT_L(8); PG8_BAR; PG8_WAIT_L(0); PG8_MMA(0, 0, At, B0); PG8_BAR; PG8_SCHED;
            PG8_LDB(B1, 1, 1); PG8_STAGE(PG8_SB(1, 0), b3, voffB);
            PG8_BAR; PG8_WAIT_L(0); PG8_MMA(0, 1, At, B1); PG8_BAR;
            PG8_LDA(At, 1, 1); PG8_STAGE(PG8_SA(1, 0), a3, voffA);
            PG8_BAR; PG8_WAIT_L(0); PG8_MMA(1, 0, At, B0); PG8_BAR; PG8_SCHED;
            PG8_STAGE(PG8_SB(1, 1), b3 + hstep, voffB);
            PG8_WAIT_V(6); PG8_BAR; PG8_MMA(1, 1, At, B1); PG8_BAR;
        }
        bool keep = false;
        if constexpr (Epi::SPLITK) { if (cur.kh == 0) { E.mid(acc, cur, wr, wc, fr, fq); keep = true; } else E(acc, cur, wr, wc, fr, fq); }
        else E(acc, cur, wr, wc, fr, fq);
        if (!has_next) break;
        if (!keep)
#pragma unroll
        for (int a = 0; a < 2; ++a)
#pragma unroll
            for (int b = 0; b < 2; ++b)
#pragma unroll
                for (int m = 0; m < 4; ++m)
#pragma unroll
                    for (int n = 0; n < 2; ++n) acc[a][b][m][n] = (f32x4){0.f, 0.f, 0.f, 0.f};
        cur = nxt; cA = nA; cB = nB; ++ui;
    }
    PG8_WAIT_V(0);
    if (wr == 0) PG8_BAR;
    PG8_BAR;
#undef PG8_SA
#undef PG8_SB
#undef PG8_STAGE
#undef PG8_LDA
#undef PG8_LDB
#undef PG8_MMA
#undef PG8_WAIT_V
#undef PG8_WAIT_L
#undef PG8_BAR
#undef PG8_SCHED
}
}
using pg8::Unit;
using pg8::HALF;
typedef float f32x2 __attribute__((ext_vector_type(2)));
typedef __bf16 bf16x2_t __attribute__((ext_vector_type(2)));
__device__ __forceinline__ unsigned pkbf(float a, float b) { f32x2 v = {a, b}; bf16x2_t r = __builtin_convertvector(v, bf16x2_t); return __builtin_bit_cast(unsigned, r); }

__host__ __device__ __forceinline__ int inproj_src_col(int r) {
    if (r < NP1) {
        const int tile = r >> 8, w = r & 255, half = w >> 7, c = w & 127;
        if (tile < 8) return (half == 0 ? 1024 : 2048) + 128 * tile + c;
        if (tile < 12) return r - 2048;
        return r;
    }
    const int r2 = r - NP1, tile = r2 >> 8, w = r2 & 255, half = w >> 7, c = w & 127;
    if (tile < 4) return 4096 + r2;
    if (tile < 12) return (half == 0 ? 6 * 1024 : 7 * 1024) + 128 * (tile - 4) + c;
    if (tile < 20) return (half == 0 ? 5 * 1024 : 8 * 1024) + 128 * (tile - 12) + c;
    if (tile < 24) return 9 * 1024 + (r2 - 20 * 256);
    return 10 * 1024 + (r2 - 24 * 256);
}

template <int CTRL> __device__ __forceinline__ float dppf(float x) { return __builtin_bit_cast(float, __builtin_amdgcn_update_dpp(0, __builtin_bit_cast(int, x), CTRL, 0xf, 0xf, true)); }
__device__ __forceinline__ float scan16_up(float x) { x += dppf<0x111>(x); x += dppf<0x112>(x); x += dppf<0x114>(x); x += dppf<0x118>(x); return x; }
__device__ __forceinline__ float scan16_dn(float x) { x += dppf<0x101>(x); x += dppf<0x102>(x); x += dppf<0x104>(x); x += dppf<0x108>(x); return x; }

template <int CTRL> __device__ __forceinline__ float dppf1(float x) { return __builtin_bit_cast(float, __builtin_amdgcn_update_dpp(0x3f800000, __builtin_bit_cast(int, x), CTRL, 0xf, 0xf, false)); }
__device__ __forceinline__ float pscan16_up(float x) { x *= dppf1<0x111>(x); x *= dppf1<0x112>(x); x *= dppf1<0x114>(x); x *= dppf1<0x118>(x); return x; }
__device__ __forceinline__ float pscan16_dn(float x) { x *= dppf1<0x101>(x); x *= dppf1<0x102>(x); x *= dppf1<0x104>(x); x *= dppf1<0x108>(x); return x; }

struct EpiPart1 {
    static constexpr bool PERM = true, SPLITK = false;
    bf16_t* full; bf16_t* et; const float* lbf; const float* lbb; int layer;
    __device__ __forceinline__ void operator()(const f32x4 (&acc)[2][2][4][2], const Unit& u, int wr, int wc, int fr_in, int fq_in) const {
        int ln_ = threadIdx.x & 63; asm volatile("" : "+v"(ln_)); const int fr = ln_ & 15, fq = ln_ >> 4; (void)fr_in; (void)fq_in;
        const int tile = u.pn;
        const int row0 = u.pm * 256 + wr * 64 + fr;
        if (tile >= 12) {
            bf16_t* base = full + (size_t)F_I * ((size_t)T_ALL * DM) + (tile - 12) * 256 + wc * 32 + 8 * fq;
#pragma unroll
            for (int ai = 0; ai < 2; ++ai)
#pragma unroll
                for (int m = 0; m < 4; ++m)
#pragma unroll
                    for (int bj = 0; bj < 2; ++bj) {
                        u32x4 w; w.x = pkbf(acc[ai][bj][m][0][0], acc[ai][bj][m][0][1]); w.y = pkbf(acc[ai][bj][m][0][2], acc[ai][bj][m][0][3]);
                        w.z = pkbf(acc[ai][bj][m][1][0], acc[ai][bj][m][1][1]); w.w = pkbf(acc[ai][bj][m][1][2], acc[ai][bj][m][1][3]);
                        *(u32x4*)(base + (size_t)(row0 + ai * HALF + m * 16) * DM + bj * HALF) = w;
                    }
            return;
        }
        if (tile >= 8) {
            const int col0 = (tile - 8) * 256 + wc * 32 + 8 * fq;
            bf16_t* qf = full + (size_t)F_QF * ((size_t)T_ALL * DM) + col0;
            bf16_t* qb = full + (size_t)F_QB * ((size_t)T_ALL * DM) + col0;
#define QPASS(qx) { u32x4 cf[2], nf[2]; \
                _Pragma("unroll") for (int bj = 0; bj < 2; ++bj) cf[bj] = *(const u32x4*)((qx) + (size_t)row0 * DM + bj * HALF); \
                _Pragma("unroll") for (int g = 0; g < 8; ++g) { \
                    const int ai = g >> 2, m = g & 3; \
                    const size_t ro = (size_t)(row0 + ai * HALF + m * 16) * DM; \
                    if (g < 7) { const size_t rn = (size_t)(row0 + ((g + 1) >> 2) * HALF + ((g + 1) & 3) * 16) * DM; \
                        _Pragma("unroll") for (int bj = 0; bj < 2; ++bj) nf[bj] = *(const u32x4*)((qx) + rn + bj * HALF); } \
                    _Pragma("unroll") for (int bj = 0; bj < 2; ++bj) { \
                        const unsigned fw[4] = {cf[bj].x, cf[bj].y, cf[bj].z, cf[bj].w}; \
                        unsigned wf[4]; \
                        _Pragma("unroll") for (int q = 0; q < 4; ++q) \
                            wf[q] = pkbf(acc[ai][bj][m][q >> 1][2 * (q & 1)] * (0.08838834764831845f * bf_lo(fw[q])), acc[ai][bj][m][q >> 1][2 * (q & 1) + 1] * (0.08838834764831845f * bf_hi(fw[q]))); \
                        u32x4 o; o.x = wf[0]; o.y = wf[1]; o.z = wf[2]; o.w = wf[3]; \
                        *(u32x4*)((qx) + ro + bj * HALF) = o; } \
                    _Pragma("unroll") for (int bj = 0; bj < 2; ++bj) cf[bj] = nf[bj]; } \
                asm volatile("" ::: "memory"); }
            QPASS(qf)
            __builtin_amdgcn_sched_barrier(0);
            QPASS(qb)
#undef QPASS
            return;
        }
        const int head = tile;
        const int colh = head * 128 + wc * 32 + 8 * fq;
        if (true) { f_body<0>(acc, u, wr, fr, colh, row0); __builtin_amdgcn_sched_barrier(0); f_body<1>(acc, u, wr, fr, colh, row0); }
    }
    template <int dirb>
    __device__ __forceinline__ void f_body(const f32x4 (&acc)[2][2][4][2], const Unit& u, int wr, int fr, int colh, int row0) const {
        bf16_t* egp = full + (size_t)(dirb ? F_QB : F_QF) * ((size_t)T_ALL * DM) + colh;
        bf16_t* kd = full + (size_t)(dirb ? F_KB : F_KF) * ((size_t)T_ALL * DM) + colh;
        const float* raw = dirb ? lbb : lbf;
        const float lbsel = layer == 0 ? 0.f : 1.f;
#pragma unroll
        for (int ai = 0; ai < 2; ++ai) {
            const int chunk = (u.pm * 256 + ai * HALF + wr * 64) >> 6;
            bf16_t* ep = et + (((size_t)dirb * NCHUNK + chunk) * 2) * DM + colh;
            unsigned oqp[4][4], okp[4][4];
#pragma unroll
            for (int c2 = 0; c2 < 4; ++c2) {
                float oq[2][4], ok[2][4], e0[2], e1[2];
#pragma unroll
                for (int h = 0; h < 2; ++h) {
                    const int c = 2 * c2 + h, n = c >> 2, jj = c & 3;
                    const float r0 = raw[colh + c], r1 = raw[DM + colh + c];
                    const float lb = lbsel * __builtin_amdgcn_rcpf(1.0f + __builtin_amdgcn_exp2f((r0 - r1) * LOG2E));
                    float fv[4], kk[4], p[4], t[4], g[4];
#pragma unroll
                    for (int m = 0; m < 4; ++m) { const float a = acc[ai][dirb][m][n][jj]; const float e = __builtin_amdgcn_exp2f(-fmaxf(a, -80.f - dirb) * LOG2E), r = __builtin_amdgcn_rcpf(1.0f + e);
                        fv[m] = fmaxf(lb + (1.0f - lb) * r, 1e-20f); kk[m] = (1.0f - lb) * (e * r); }
                    if (!dirb) {
#pragma unroll
                        for (int m = 0; m < 4; ++m) { p[m] = pscan16_up(fv[m]); t[m] = __shfl(p[m], 15, 16); }
                        g[0] = p[0]; g[1] = p[1] * t[0]; g[2] = p[2]; g[3] = p[3] * t[2]; e0[h] = t[0] * t[1]; e1[h] = t[2] * t[3];
                    } else {
#pragma unroll
                        for (int m = 0; m < 4; ++m) { p[m] = pscan16_dn(fv[m]); t[m] = __shfl(p[m], 0, 16); }
                        g[3] = p[3]; g[2] = p[2] * t[3]; g[1] = p[1]; g[0] = p[0] * t[1]; e0[h] = t[2] * t[3]; e1[h] = t[0] * t[1];
                    }
#pragma unroll
                    for (int m = 0; m < 4; ++m) { const float eg = fmaxf(g[m], 7.888609052210118e-31f);
                        oq[h][m] = eg; ok[h][m] = kk[m] * __builtin_amdgcn_rcpf(eg); }
                    __builtin_amdgcn_sched_barrier(0);
                }
#pragma unroll
                for (int m = 0; m < 4; ++m) { oqp[m][c2] = pkbf(oq[0][m], oq[1][m]); okp[m][c2] = pkbf(ok[0][m], ok[1][m]); }
                *(unsigned*)(ep + 2 * c2) = pkbf(e0[0], e0[1]); *(unsigned*)(ep + DM + 2 * c2) = pkbf(e1[0], e1[1]);
            }
#pragma unroll
            for (int m = 0; m < 4; ++m) {
                const size_t ro = (size_t)(row0 + ai * HALF + m * 16) * DM;
                u32x4 w; w.x = oqp[m][0]; w.y = oqp[m][1]; w.z = oqp[m][2]; w.w = oqp[m][3];
                *(u32x4*)(egp + ro) = w;
                w.x = okp[m][0]; w.y = okp[m][1]; w.z = okp[m][2]; w.w = okp[m][3];
                *(u32x4*)(kd + ro) = w;
            }
            asm volatile("" ::: "memory");
        }
    }
};

struct EpiPart2 {
    static constexpr bool PERM = true, SPLITK = false;
    bf16_t* arr;
    __device__ __forceinline__ void operator()(const f32x4 (&acc)[2][2][4][2], const Unit& u, int wr, int wc, int fr_in, int fq_in) const {
        int fr = fr_in, fq = fq_in; asm volatile("" : "+v"(fr), "+v"(fq));
        const int tile = u.pn;
        const int row0 = u.pm * 256 + wr * 64 + fr;
        if (tile >= 4 && tile < 20) {
            const bool isU = tile < 12;
            bf16_t* base = arr + (size_t)(isU ? S_U : S_M) * ((size_t)TP_MAX * DM) + (isU ? (tile - 4) : (tile - 12)) * 128 + wc * 32 + 8 * fq;
#pragma unroll
            for (int ai = 0; ai < 2; ++ai)
#pragma unroll
                for (int m = 0; m < 4; ++m) {
                    float o[8];
#pragma unroll
                    for (int n = 0; n < 2; ++n)
#pragma unroll
                        for (int j = 0; j < 4; ++j) { const float a = acc[ai][0][m][n][j], b = acc[ai][1][m][n][j];
                            o[4 * n + j] = isU ? a * b : a * (b * fsigmoid(b)); }
                    u32x4 w; w.x = pkbf(o[0], o[1]); w.y = pkbf(o[2], o[3]); w.z = pkbf(o[4], o[5]); w.w = pkbf(o[6], o[7]);
                    *(u32x4*)(base + (size_t)(row0 + ai * HALF + m * 16) * DM) = w;
                }
            return;
        }
        const bool silu = tile < 4;
        const int aidx = tile < 4 ? S_SZA : (tile < 24 ? S_SGA : S_SGB);
        bf16_t* base = arr + (size_t)aidx * ((size_t)TP_MAX * DM) + (tile & 3) * 256 + wc * 32 + 8 * fq;
#pragma unroll
        for (int ai = 0; ai < 2; ++ai)
#pragma unroll
            for (int m = 0; m < 4; ++m)
#pragma unroll
                for (int bj = 0; bj < 2; ++bj) {
                    float o[8];
#pragma unroll
                    for (int n = 0; n < 2; ++n)
#pragma unroll
                        for (int j = 0; j < 4; ++j) { const float a = acc[ai][bj][m][n][j]; const float s = fsigmoid(a); o[4 * n + j] = silu ? a * s : s; }
                    u32x4 w; w.x = pkbf(o[0], o[1]); w.y = pkbf(o[2], o[3]); w.z = pkbf(o[4], o[5]); w.w = pkbf(o[6], o[7]);
                    *(u32x4*)(base + (size_t)(row0 + ai * HALF + m * 16) * DM + bj * HALF) = w;
                }
    }
};

struct EpiMerge {
    static constexpr bool PERM = true, SPLITK = true;
    const bf16_t* sga; const bf16_t* sgb; bf16_t* outp;
    __device__ __forceinline__ void mid(f32x4 (&acc)[2][2][4][2], const Unit& u, int wr, int wc, int fr_in, int fq_in) const {
        int fr = fr_in, fq = fq_in; asm volatile("" : "+v"(fr), "+v"(fq));
        const int row0 = u.pm * 256 + wr * 64 + fr, col0 = u.pn * 256 + wc * 32 + 8 * fq;
#pragma unroll
        for (int ai = 0; ai < 2; ++ai)
#pragma unroll
            for (int m = 0; m < 4; ++m) {
                asm volatile("" ::: "memory");
#pragma unroll
                for (int bj = 0; bj < 2; ++bj) {
                    const size_t off = (size_t)(row0 + ai * HALF + m * 16) * DM + col0 + bj * HALF;
                    const u32x4 a = *(const u32x4*)(sga + off), b = *(const u32x4*)(sgb + off);
                    const unsigned aw[4] = {a.x, a.y, a.z, a.w}, bw[4] = {b.x, b.y, b.z, b.w};
#pragma unroll
                    for (int q = 0; q < 4; ++q) {
                        const float r0 = bf_lo(aw[q]) * __builtin_amdgcn_rcpf(fmaxf(bf_lo(bw[q]), 1e-30f));
                        const float r1 = bf_hi(aw[q]) * __builtin_amdgcn_rcpf(fmaxf(bf_hi(bw[q]), 1e-30f));
                        acc[ai][bj][m][q >> 1][2 * (q & 1)] *= r0; acc[ai][bj][m][q >> 1][2 * (q & 1) + 1] *= r1;
                    }
                }
                asm volatile("" : "+v"(acc[ai][0][m][0]), "+v"(acc[ai][0][m][1]), "+v"(acc[ai][1][m][0]), "+v"(acc[ai][1][m][1]));
            }
    }
    __device__ __forceinline__ void operator()(const f32x4 (&acc)[2][2][4][2], const Unit& u, int wr, int wc, int fr_in, int fq_in) const {
        int fr = fr_in, fq = fq_in; asm volatile("" : "+v"(fr), "+v"(fq));
        const int row0 = u.pm * 256 + wr * 64 + fr, col0 = u.pn * 256 + wc * 32 + 8 * fq;
        u32x4 cur[2], nxt[2];
#pragma unroll
        for (int bj = 0; bj < 2; ++bj) cur[bj] = *(const u32x4*)(sgb + (size_t)row0 * DM + col0 + bj * HALF);
#pragma unroll
        for (int g = 0; g < 8; ++g) {
            const int ai = g >> 2, m = g & 3;
            const size_t ro = (size_t)(row0 + ai * HALF + m * 16) * DM + col0;
            if (g < 7) { const int ai2 = (g + 1) >> 2, m2 = (g + 1) & 3; const size_t rn = (size_t)(row0 + ai2 * HALF + m2 * 16) * DM + col0;
#pragma unroll
                for (int bj = 0; bj < 2; ++bj) nxt[bj] = *(const u32x4*)(sgb + rn + bj * HALF); }
#pragma unroll
            for (int bj = 0; bj < 2; ++bj) {
                const unsigned bw[4] = {cur[bj].x, cur[bj].y, cur[bj].z, cur[bj].w};
                unsigned w[4];
#pragma unroll
                for (int q = 0; q < 4; ++q) {
                    const float s0 = fmaxf(bf_lo(bw[q]), 1e-30f), s1 = fmaxf(bf_hi(bw[q]), 1e-30f);
                    w[q] = pkbf(acc[ai][bj][m][q >> 1][2 * (q & 1)] * s0, acc[ai][bj][m][q >> 1][2 * (q & 1) + 1] * s1);
                }
                u32x4 ov; ov.x = w[0]; ov.y = w[1]; ov.z = w[2]; ov.w = w[3];
                *(u32x4*)(outp + ro + bj * HALF) = ov;
            }
#pragma unroll
            for (int bj = 0; bj < 2; ++bj) cur[bj] = nxt[bj];
        }
    }
};

struct EpiOut {
    static constexpr bool PERM = false, SPLITK = false;
    const float* xp; const float* xs; float* out; int layer; int tok0;
    __device__ __forceinline__ void operator()(const f32x4 (&acc)[2][2][4][2], const Unit& u, int wr, int wc, int fr_in, int fq_in) const {
        int fr = fr_in, fq = fq_in; asm volatile("" : "+v"(fr), "+v"(fq));
        const int trow0 = tok0 + u.pm * 256;
        const float* res;
        if (layer == 0) res = (trow0 < T_PROMPT) ? xp + (size_t)trow0 * DM : xs + (size_t)(trow0 - T_PROMPT) * DM;
        else res = out + (size_t)trow0 * DM;
        float* o = out + (size_t)trow0 * DM;
        const int r0 = wr * 64 + fr, col0 = u.pn * 256 + wc * 32 + 4 * fq;
        f32x4 cur[4], nxt[4];
#pragma unroll
        for (int q = 0; q < 4; ++q) cur[q] = *(const f32x4*)(res + (size_t)r0 * DM + col0 + (q >> 1) * HALF + (q & 1) * 16);
#pragma unroll
        for (int g = 0; g < 8; ++g) {
            const int ai = g >> 2, m = g & 3;
            const size_t ro = (size_t)(r0 + ai * HALF + m * 16) * DM + col0;
            if (g < 7) { const int ai2 = (g + 1) >> 2, m2 = (g + 1) & 3; const size_t rn = (size_t)(r0 + ai2 * HALF + m2 * 16) * DM + col0;
#pragma unroll
                for (int q = 0; q < 4; ++q) nxt[q] = *(const f32x4*)(res + rn + (q >> 1) * HALF + (q & 1) * 16); }
#pragma unroll
            for (int q = 0; q < 4; ++q) *(f32x4*)(o + ro + (q >> 1) * HALF + (q & 1) * 16) = cur[q] + acc[ai][q >> 1][m][q & 1];
#pragma unroll
            for (int q = 0; q < 4; ++q) cur[q] = nxt[q];
        }
    }
};
__device__ __forceinline__ bf16_t* full_ptr(const Params& P, int a) { return (bf16_t*)(P.ws + WS_FULL + (size_t)a * AB); }
__device__ __forceinline__ bf16_t* pass_ptr(const Params& P, int a) { return (bf16_t*)(P.ws + WS_PASS + (size_t)a * PB); }

__device__ __forceinline__ void tr_item(const float* W, int N, int k0, int srcc0, bf16_t* dst, int dstride, LAS float* scr, int lane) {
#pragma unroll 8
    for (int i = 0; i < 32; ++i) { const int kk = 2 * i + (lane >> 5); scr[kk * 33 + (lane & 31)] = W[(size_t)(k0 + kk) * N + srcc0 + (lane & 31)]; }
    asm volatile("s_waitcnt lgkmcnt(0)" ::: "memory");
    const int c = lane & 7;
#pragma unroll
    for (int j = 0; j < 4; ++j) { const int n = (lane >> 3) + 8 * j; const LAS float* s = scr + (8 * c) * 33 + n;
        u32x4 o; o.x = cvt_pk_bf16(s[0 * 33], s[1 * 33]); o.y = cvt_pk_bf16(s[2 * 33], s[3 * 33]); o.z = cvt_pk_bf16(s[4 * 33], s[5 * 33]); o.w = cvt_pk_bf16(s[6 * 33], s[7 * 33]);
        *(u32x4*)(dst + (size_t)n * dstride + 8 * c) = o; }
    asm volatile("s_waitcnt lgkmcnt(0)" ::: "memory");
}

__device__ __forceinline__ void phase_prep(const Params& P, LAS unsigned char* lds, int layer, int gw, int NGW, int wave, int lane) {
    LAS float* scr = (LAS float*)(lds + wave * 16384);
    constexpr int I_IN = 16 * (NWIN / 32), I_SQ = 16 * 32;
    constexpr int PER_LAYER = I_IN + 3 * I_SQ;
    for (int it = gw; it < PER_LAYER; it += NGW) {
        int r = it;
        if (r < I_IN) { const int kb = r / (NWIN / 32), nb = r % (NWIN / 32); const int n0 = nb * 32;
            bf16_t* dst = (bf16_t*)(P.ws + WS_WIN) + (size_t)n0 * DM + kb * 64;
            tr_item(P.w_in + (size_t)layer * DM * NPROJ, NPROJ, kb * 64, inproj_src_col(n0), dst, DM, scr, lane); continue; }
        r -= I_IN;
        const int which = r / I_SQ; r %= I_SQ; const int kb = r / 32, nb = r % 32, n0 = nb * 32;
        if (which == 0) tr_item(P.w_a + (size_t)layer * DM * DM, DM, kb * 64, n0, (bf16_t*)(P.ws + WS_WA) + (size_t)n0 * DM + kb * 64, DM, scr, lane);
        else if (which == 1) tr_item(P.w_b + (size_t)layer * DM * DM, DM, kb * 64, n0, (bf16_t*)(P.ws + WS_WB) + (size_t)n0 * DM + kb * 64, DM, scr, lane);
        else tr_item(P.w_o + (size_t)layer * DM * DM, DM, kb * 64, n0, (bf16_t*)(P.ws + WS_WO) + (size_t)n0 * DM + kb * 64, DM, scr, lane);
    }
}

__device__ __forceinline__ const float* x_row(const Params& P, int layer, int tok) {
    if (layer == 0) return tok < T_PROMPT ? P.xp + (size_t)tok * DM : P.xs + (size_t)(tok - T_PROMPT) * DM;
    return P.out + (size_t)tok * DM;
}

__device__ __forceinline__ void phase_rms(const Params& P, int layer, int tok0, int Tp, int gw, int NGW, int lane) {
    bf16_t* H = full_ptr(P, F_H) + (size_t)tok0 * DM;
    const float* g = P.norm_g + layer * DM;
    f32x4 gv[4];
#pragma unroll
    for (int j = 0; j < 4; ++j) gv[j] = *(const f32x4*)(g + 4 * lane + 256 * j);
    for (int lt = gw; lt < Tp; lt += NGW) {
        const float* xr = x_row(P, layer, tok0 + lt);
        f32x4 v[4]; float s = 0.f;
#pragma unroll
        for (int j = 0; j < 4; ++j) { v[j] = *(const f32x4*)(xr + 4 * lane + 256 * j); s += (v[j].x * v[j].x + v[j].y * v[j].y) + (v[j].z * v[j].z + v[j].w * v[j].w); }
        const float rstd = rsqrtf(wave_sum(s) * (1.f / DM) + EPS);
#pragma unroll
        for (int j = 0; j < 4; ++j) { u32x2 o; o.x = cvt_pk_bf16(v[j].x * rstd * gv[j].x, v[j].y * rstd * gv[j].y); o.y = cvt_pk_bf16(v[j].z * rstd * gv[j].z, v[j].w * rstd * gv[j].w);
            *(u32x2*)(H + (size_t)lt * DM + 4 * lane + 256 * j) = o; }
    }
}

__device__ __forceinline__ void phase_final(const Params& P, int gw, int NGW, int lane) {
    f32x4 gv[4];
#pragma unroll
    for (int j = 0; j < 4; ++j) gv[j] = *(const f32x4*)(P.final_g + 4 * lane + 256 * j);
    for (int t = gw; t < T_ALL; t += NGW) {
        float* xr = P.out + (size_t)t * DM;
        f32x4 v[4]; float s = 0.f;
#pragma unroll
        for (int j = 0; j < 4; ++j) { v[j] = *(const f32x4*)(xr + 4 * lane + 256 * j); s += (v[j].x * v[j].x + v[j].y * v[j].y) + (v[j].z * v[j].z + v[j].w * v[j].w); }
        const float rstd = rsqrtf(wave_sum(s) * (1.f / DM) + EPS);
#pragma unroll
        for (int j = 0; j < 4; ++j) *(f32x4*)(xr + 4 * lane + 256 * j) = v[j] * rstd * gv[j];
    }
}

__device__ __forceinline__ void unpack8(const u32x4 w, float* o) {
    o[0] = bf_lo(w.x); o[1] = bf_hi(w.x); o[2] = bf_lo(w.y); o[3] = bf_hi(w.y); o[4] = bf_lo(w.z); o[5] = bf_hi(w.z); o[6] = bf_lo(w.w); o[7] = bf_hi(w.w);
}
__device__ __forceinline__ u32x4 pack8(const float* o) { u32x4 w; w.x = cvt_pk_bf16(o[0], o[1]); w.y = cvt_pk_bf16(o[2], o[3]); w.z = cvt_pk_bf16(o[4], o[5]); w.w = cvt_pk_bf16(o[6], o[7]); return w; }

__device__ __forceinline__ void phase_combine(const Params& P, int layer, int tok0, int Tp, int gw, int NGW, int lane) {
    const bf16_t* OF = full_ptr(P, F_QF) + (size_t)tok0 * DM; const bf16_t* OB = full_ptr(P, F_QB) + (size_t)tok0 * DM;
    bf16_t* SZ = pass_ptr(P, S_SZA); const bf16_t* U = pass_ptr(P, S_U); bf16_t* Mm = pass_ptr(P, S_M);
    const int c0 = lane * 16;
    float hg[16], w0[16], w1[16], w2[16], cb[16];
#pragma unroll
    for (int j = 0; j < 16; ++j) { hg[j] = P.hnorm_g[layer * DM + c0 + j]; w0[j] = P.conv_w[(layer * 3 + 0) * DM + c0 + j]; w1[j] = P.conv_w[(layer * 3 + 1) * DM + c0 + j];
        w2[j] = P.conv_w[(layer * 3 + 2) * DM + c0 + j]; cb[j] = P.conv_b[layer * DM + c0 + j]; }
    for (int lt = gw; lt < Tp; lt += NGW) {
        const int tok = tok0 + lt;
        const int L = tok < T_PROMPT ? 8192 : 4096; const int pos = tok & (L - 1);
        const size_t ro = (size_t)lt * DM + c0;
        float a[16], b[16], z[16];
        unpack8(*(const u32x4*)(OF + ro), a); unpack8(*(const u32x4*)(OF + ro + 8), a + 8);
        unpack8(*(const u32x4*)(OB + ro), b); unpack8(*(const u32x4*)(OB + ro + 8), b + 8);
        unpack8(*(const u32x4*)(SZ + ro), z); unpack8(*(const u32x4*)(SZ + ro + 8), z + 8);
        float ss = 0.f;
#pragma unroll
        for (int j = 0; j < 16; ++j) { a[j] += b[j]; ss += a[j] * a[j]; }
        ss += __shfl_xor(ss, 1); ss += __shfl_xor(ss, 2); ss += __shfl_xor(ss, 4);
        const float rstd = rsqrtf(ss * (1.f / 128.f) + EPS);
#pragma unroll
        for (int j = 0; j < 16; ++j) a[j] = a[j] * rstd * hg[j] * z[j];
        *(u32x4*)(SZ + ro) = pack8(a); *(u32x4*)(SZ + ro + 8) = pack8(a + 8);
        float up[16], uc[16], un[16], mm[16];
        unpack8(*(const u32x4*)(U + ro), uc); unpack8(*(const u32x4*)(U + ro + 8), uc + 8);
        unpack8(*(const u32x4*)(Mm + ro), mm); unpack8(*(const u32x4*)(Mm + ro + 8), mm + 8);
        if (pos > 0) { unpack8(*(const u32x4*)(U + ro - DM), up); unpack8(*(const u32x4*)(U + ro - DM + 8), up + 8); }
        else {
#pragma unroll
            for (int j = 0; j < 16; ++j) up[j] = 0.f; }
        if (pos < L - 1) { unpack8(*(const u32x4*)(U + ro + DM), un); unpack8(*(const u32x4*)(U + ro + DM + 8), un + 8); }
        else {
#pragma unroll
            for (int j = 0; j < 16; ++j) un[j] = 0.f; }
#pragma unroll
        for (int j = 0; j < 16; ++j) mm[j] = mm[j] * (w0[j] * up[j] + w1[j] * uc[j] + w2[j] * un[j] + cb[j]);
        *(u32x4*)(Mm + ro) = pack8(mm); *(u32x4*)(Mm + ro + 8) = pack8(mm + 8);
    }
}
#define MFMA16(a, b, c) __builtin_amdgcn_mfma_f32_16x16x32_bf16((a), (b), (c), 0, 0, 0)

constexpr int SC_E01 = 0, SC_QT = 512, SC_KD = 17920, SC_KO = 35328, SC_QG = 44032, SC_KCT = 52736, SC_VT = 71296, SC_P = 89856, SC_END = 99072;
constexpr int RS = 272;
constexpr int TS = 144;

__device__ __forceinline__ void scan_item(const Params& P, LAS unsigned char* lds, int base, int L, int head, int dir, int tid) {
    const int wave = __builtin_amdgcn_readfirstlane(tid >> 6), lane = tid & 63, r16 = lane & 15, q4 = lane >> 4;
    const int row = tid >> 3, cs = tid & 7, c0 = cs * 16;
    bf16_t* QD = full_ptr(P, dir ? F_QB : F_QF); const bf16_t* KDg = full_ptr(P, dir ? F_KB : F_KF); const bf16_t* I = full_ptr(P, F_I);
    const bf16_t* ET = (const bf16_t*)(P.ws + WS_ET) + (size_t)dir * NCHUNK * 2 * DM + head * 128 + c0;
    const int nch = L >> 6, chunk0 = base >> 6;
    LAS float* E01 = (LAS float*)(lds + SC_E01);
    f32x4 S[8];
#pragma unroll
    for (int i = 0; i < 8; ++i) S[i] = (f32x4){0.f, 0.f, 0.f, 0.f};
    u32x4 rq[2], rk[2], rv[2], re0[2], re1[2];
    {   const int ci = dir ? nch - 1 : 0; const size_t go = (size_t)(base + ci * 64 + (dir ? 63 - row : row)) * DM + head * 128 + c0;
        rq[0] = *(const u32x4*)(QD + go); rq[1] = *(const u32x4*)(QD + go + 8); rk[0] = *(const u32x4*)(KDg + go); rk[1] = *(const u32x4*)(KDg + go + 8);
        rv[0] = *(const u32x4*)(I + go); rv[1] = *(const u32x4*)(I + go + 8);
        const bf16_t* ep = ET + (size_t)(chunk0 + ci) * 2 * DM;
        re0[0] = *(const u32x4*)(ep); re0[1] = *(const u32x4*)(ep + 8); re1[0] = *(const u32x4*)(ep + DM); re1[1] = *(const u32x4*)(ep + DM + 8); }
#pragma unroll 1
    for (int n = 0; n < nch; ++n) {
        const int ci = dir ? nch - 1 - n : n;
        const size_t gcur = (size_t)(base + ci * 64 + (dir ? 63 - row : row)) * DM + head * 128 + c0;
        {   float qv[16], kv[16], vv[16], e0[16], e1[16];
            unpack8(rq[0], qv); unpack8(rq[1], qv + 8); unpack8(rk[0], kv); unpack8(rk[1], kv + 8); unpack8(rv[0], vv); unpack8(rv[1], vv + 8);
            unpack8(re0[0], e0); unpack8(re0[1], e0 + 8); unpack8(re1[0], e1); unpack8(re1[1], e1 + 8);
            *(LAS u32x4*)(lds + SC_QT + row * RS + c0 * 2) = rq[0]; *(LAS u32x4*)(lds + SC_QT + row * RS + c0 * 2 + 16) = rq[1];
            *(LAS u32x4*)(lds + SC_KD + row * RS + c0 * 2) = rk[0]; *(LAS u32x4*)(lds + SC_KD + row * RS + c0 * 2 + 16) = rk[1];
            float ox[16], okc[16];
            const bool lo = row < 32;
#pragma unroll
            for (int j = 0; j < 16; ++j) {
                if (lo) { ox[j] = kv[j] * e0[j]; okc[j] = ox[j] * e1[j]; }
                else { ox[j] = qv[j] * e0[j]; okc[j] = kv[j] * e1[j]; }
            }
            u32x4 w0, w1;
            w0.x = pkbf(ox[0], ox[1]); w0.y = pkbf(ox[2], ox[3]); w0.z = pkbf(ox[4], ox[5]); w0.w = pkbf(ox[6], ox[7]);
            w1.x = pkbf(ox[8], ox[9]); w1.y = pkbf(ox[10], ox[11]); w1.z = pkbf(ox[12], ox[13]); w1.w = pkbf(ox[14], ox[15]);
            if (lo) { *(LAS u32x4*)(lds + SC_KO + row * RS + c0 * 2) = w0; *(LAS u32x4*)(lds + SC_KO + row * RS + c0 * 2 + 16) = w1; }
            else { *(LAS u32x4*)(lds + SC_QG + (row - 32) * RS + c0 * 2) = w0; *(LAS u32x4*)(lds + SC_QG + (row - 32) * RS + c0 * 2 + 16) = w1; }
#pragma unroll
            for (int j = 0; j < 16; ++j) {
                *(LAS bf16_t*)(lds + SC_KCT + (c0 + j) * TS + cs * 16 + row * 2) = (bf16_t)(pkbf(okc[j], 0.f) & 0xffffu);
                *(LAS bf16_t*)(lds + SC_VT + (c0 + j) * TS + cs * 16 + row * 2) = (bf16_t)(pkbf(vv[j], 0.f) & 0xffffu);
            }
            if (row == 0) {
#pragma unroll
                for (int j = 0; j < 16; ++j) E01[c0 + j] = e0[j] * e1[j];
            }
        }
        if (n + 1 < nch) { const int cn = dir ? nch - 2 - n : n + 1; const size_t go = (size_t)(base + cn * 64 + (dir ? 63 - row : row)) * DM + head * 128 + c0;
            rq[0] = *(const u32x4*)(QD + go); rq[1] = *(const u32x4*)(QD + go + 8); rk[0] = *(const u32x4*)(KDg + go); rk[1] = *(const u32x4*)(KDg + go + 8);
            rv[0] = *(const u32x4*)(I + go); rv[1] = *(const u32x4*)(I + go + 8);
            const bf16_t* ep = ET + (size_t)(chunk0 + cn) * 2 * DM;
            re0[0] = *(const u32x4*)(ep); re0[1] = *(const u32x4*)(ep + 8); re1[0] = *(const u32x4*)(ep + DM); re1[1] = *(const u32x4*)(ep + DM + 8); }
        __syncthreads();
#pragma unroll
        for (int e = 0; e < 2; ++e) {
            const int ti = wave >> 1, sj = 2 * (wave & 1) + e;
            if (sj > ti) {
                if ((ti == 0 && sj == 1) || (ti == 2 && sj == 3)) {
#pragma unroll
                    for (int i = 0; i < 4; ++i) *(LAS bf16_t*)(lds + SC_P + (16 * ti + 4 * q4 + i) * TS + (16 * sj + r16) * 2) = 0;
                }
                continue;
            }
            const int kbase = ((ti >> 1) == (sj >> 1)) ? SC_KD : SC_KO;
            f32x4 acc = (f32x4){0.f, 0.f, 0.f, 0.f};
#pragma unroll
            for (int ks = 0; ks < 4; ++ks) {
                const bf16x8 a = *(const LAS bf16x8*)(lds + SC_QT + (16 * ti + r16) * RS + (32 * ks + 8 * q4) * 2);
                const bf16x8 b = *(const LAS bf16x8*)(lds + kbase + (16 * sj + r16) * RS + (32 * ks + 8 * q4) * 2);
                acc = MFMA16(a, b, acc);
            }
#pragma unroll
            for (int i = 0; i < 4; ++i) {
                float v = acc[i];
                if (ti == sj && r16 > 4 * q4 + i) v = 0.f;
                *(LAS bf16_t*)(lds + SC_P + (16 * ti + 4 * q4 + i) * TS + (16 * sj + r16) * 2) = (bf16_t)(pkbf(v, 0.f) & 0xffffu);
            }
        }
        __syncthreads();
        f32x4 o[4];
#pragma unroll
        for (int i = 0; i < 4; ++i) o[i] = (f32x4){0.f, 0.f, 0.f, 0.f};
#pragma unroll
        for (int ks = 0; ks < 4; ++ks) {
            u32x4 bw; bw.x = pkbf(S[2 * ks][0], S[2 * ks][1]); bw.y = pkbf(S[2 * ks][2], S[2 * ks][3]); bw.z = pkbf(S[2 * ks + 1][0], S[2 * ks + 1][1]); bw.w = pkbf(S[2 * ks + 1][2], S[2 * ks + 1][3]);
            const bf16x8 b = __builtin_bit_cast(bf16x8, bw);
#pragma unroll
            for (int ti = 0; ti < 4; ++ti) {
                const int abase = (ti < 2) ? SC_QT + (16 * ti + r16) * RS : SC_QG + (16 * (ti - 2) + r16) * RS;
                const u32x2 alo = *(const LAS u32x2*)(lds + abase + (32 * ks + 4 * q4) * 2), ahi = *(const LAS u32x2*)(lds + abase + (32 * ks + 16 + 4 * q4) * 2);
                u32x4 aw; aw.x = alo.x; aw.y = alo.y; aw.z = ahi.x; aw.w = ahi.y;
                o[ti] = MFMA16(__builtin_bit_cast(bf16x8, aw), b, o[ti]);
            }
        }
        bf16x8 vb[2];
#pragma unroll
        for (int ss = 0; ss < 2; ++ss) vb[ss] = *(const LAS bf16x8*)(lds + SC_VT + (16 * wave + r16) * TS + wave * 16 + (32 * ss + 8 * q4) * 2);
#pragma unroll
        for (int ti = 0; ti < 4; ++ti)
#pragma unroll
            for (int ss = 0; ss <= (ti >> 1); ++ss) {
                const bf16x8 a = *(const LAS bf16x8*)(lds + SC_P + (16 * ti + r16) * TS + (32 * ss + 8 * q4) * 2);
                o[ti] = MFMA16(a, vb[ss], o[ti]);
            }
#pragma unroll
        for (int kt = 0; kt < 8; ++kt) {
            const f32x4 e4 = *(const LAS f32x4*)(E01 + 16 * kt + 4 * q4);
            S[kt] = S[kt] * e4;
#pragma unroll
            for (int ss = 0; ss < 2; ++ss) {
                const bf16x8 a = *(const LAS bf16x8*)(lds + SC_KCT + (16 * kt + r16) * TS + kt * 16 + (32 * ss + 8 * q4) * 2);
                S[kt] = MFMA16(a, vb[ss], S[kt]);
            }
        }
#pragma unroll
        for (int ti = 0; ti < 4; ++ti)
#pragma unroll
            for (int i = 0; i < 4; ++i) *(LAS bf16_t*)(lds + SC_KD + (16 * ti + 4 * q4 + i) * RS + (16 * wave + r16) * 2) = (bf16_t)(pkbf(o[ti][i], 0.f) & 0xffffu);
        __syncthreads();
        {   const u32x4 w0 = *(const LAS u32x4*)(lds + SC_KD + row * RS + c0 * 2), w1 = *(const LAS u32x4*)(lds + SC_KD + row * RS + c0 * 2 + 16);
            *(u32x4*)(QD + gcur) = w0; *(u32x4*)(QD + gcur + 8) = w1; }
    }
    __syncthreads();
}

__device__ __forceinline__ void scan_one(const Params& P, LAS unsigned char* lds, int it, int tid) {
    const int seq = it >> 4, head = (it >> 1) & 7, dir = it & 1;
    int base, L;
    if (seq < 2) { base = seq * 8192; L = 8192; } else { base = T_PROMPT + (seq - 2) * 4096; L = 4096; }
    scan_item(P, lds, base, L, head, dir, tid);
}
__device__ __forceinline__ void phase_scan(const Params& P, LAS unsigned char* lds, int tid) {
    const int b = blockIdx.x, G = gridDim.x;
    if (G >= 256) {
        if (b < 256) scan_one(P, lds, b, tid);
        if (b >= 32 && b < 64) scan_one(P, lds, 256 + (b - 32), tid);
    } else {
        for (int it = b; it < 288; it += G) scan_one(P, lds, it, tid);
    }
}
#define XB_TMO      128
#define XB_XCNT(j)  (256  + 64 * (j))
#define XB_XSUB(j)  (1280 + 64 * (j))
#define XB_XGEN(j)  (2304 + 64 * (j))
#define XB_TOP      3328
#define XB_TOPGEN   3392
#define XCD_BAR_WORDS 3456
#define XB_SPIN_CAP (1u << 22)
__device__ __forceinline__ unsigned xb_ld(unsigned* p)              { return __hip_atomic_load(p, __ATOMIC_RELAXED, __HIP_MEMORY_SCOPE_AGENT); }
__device__ __forceinline__ unsigned xb_add(unsigned* p, unsigned v) { return __hip_atomic_fetch_add(p, v, __ATOMIC_RELAXED, __HIP_MEMORY_SCOPE_AGENT); }
__device__ __forceinline__ unsigned xb_xcc_id() { return (unsigned)__builtin_amdgcn_s_getreg((3 << 11) | 20) & 0xFu; }
#define XB_SPIN(cond, bar) do { unsigned _sp = 0; while (cond) { __builtin_amdgcn_s_sleep(1); \
    if ((++_sp & 255u) == 0u) { if (xb_ld(&(bar)[XB_TMO])) break; if (_sp > XB_SPIN_CAP) { atomicAdd(&(bar)[XB_TMO], 1u); break; } } } } while (0)
struct XcdBarrier { unsigned* bar; unsigned x; volatile LAS unsigned* st; };
__device__ __forceinline__ void xcd_barrier_complete(unsigned* bar, unsigned x, unsigned& nloc, unsigned& nx) {
    const unsigned G = gridDim.x * gridDim.y * gridDim.z;
    unsigned sum, cnt, mine, sp = 0u;
    for (;;) {
        sum = 0u; cnt = 0u; mine = 0u;
#pragma unroll
        for (unsigned j = 0; j < 16; ++j) { const unsigned c = xb_ld(&bar[XB_XCNT(j)]); sum += c; cnt += (c > 0u) ? 1u : 0u; mine = (j == x) ? c : mine; }
        if (sum == G) break;
        __builtin_amdgcn_s_sleep(1);
        if ((++sp & 255u) == 0u) { if (xb_ld(&bar[XB_TMO])) break; if (sp > XB_SPIN_CAP) { atomicAdd(&bar[XB_TMO], 1u); break; } }
    }
    nloc = mine > 0u ? mine : 1u; nx = cnt > 0u ? cnt : 1u;
}
__device__ __forceinline__ void xcd_barrier(const XcdBarrier& b) {
    asm volatile("s_waitcnt vmcnt(0)" ::: "memory");
    __syncthreads();
    if (threadIdx.x == 0) {
        unsigned* bar = b.bar;
        __builtin_amdgcn_s_waitcnt(0);
        unsigned nloc = b.st[0], nx = b.st[1];
        if (nloc == 0u) { xcd_barrier_complete(bar, b.x, nloc, nx); b.st[0] = nloc; b.st[1] = nx; }
        const unsigned old = xb_add(&bar[XB_XSUB(b.x)], 1u);
        const unsigned gen = old / nloc;
        if (old + 1u == (gen + 1u) * nloc) {
            __builtin_amdgcn_fence(__ATOMIC_RELEASE, "agent");
            asm volatile("s_waitcnt vmcnt(0)" ::: "memory");
            const unsigned og = xb_add(&bar[XB_TOP], 1u);
            const unsigned tg = og / nx;
            if (og + 1u == (tg + 1u) * nx) xb_add(&bar[XB_TOPGEN], 1u);
            else XB_SPIN(xb_ld(&bar[XB_TOPGEN]) == tg, bar);
            __builtin_amdgcn_fence(__ATOMIC_ACQUIRE, "agent");
            xb_add(&bar[XB_XGEN(b.x)], 1u);
            asm volatile("s_waitcnt vmcnt(0)" ::: "memory");
        } else {
            XB_SPIN(xb_ld(&bar[XB_XGEN(b.x)]) == gen, bar);
            __builtin_amdgcn_fence(__ATOMIC_ACQUIRE, "agent");
            asm volatile("s_waitcnt vmcnt(0)" ::: "memory");
        }
    }
    __syncthreads();
}

typedef const __attribute__((address_space(4))) Params* KParams;
__device__ __forceinline__ Params getP(KParams kp) { asm volatile("" : "+s"(kp)); const Params* gp = (const Params*)kp; return *gp; }
__device__ __forceinline__ int opq(int x) { asm volatile("" : "+s"(x)); return x; }
#define PH(call) do { const Params P = getP(kp); int t_ = threadIdx.x; asm volatile("" : "+v"(t_)); const int tid = t_, wave = tid >> 6, lane = tid & 63, gw = blockIdx.x * 8 + wave; (void)lane; (void)gw; call; } while (0)
#define GSYNC() do { const Params P = getP(kp); XcdBarrier xb_; xb_.bar = (unsigned*)(P.ws + WS_BAR); xb_.x = xb_xcc_id(); xb_.st = (volatile LAS unsigned*)(lds + BAR_LDS); xcd_barrier(xb_); } while (0)
__global__ __launch_bounds__(512, 2) void mega_fwd(Params Parg) {
    KParams kp = (KParams)__builtin_amdgcn_kernarg_segment_ptr();
    extern __shared__ __attribute__((aligned(16))) unsigned char shm[];
    LAS unsigned char* lds = (LAS unsigned char*)shm;
    cg::grid_group grid = cg::this_grid();
    const int G = gridDim.x, NGW = G * 8;
    if (threadIdx.x == 0) { ((volatile LAS unsigned*)(lds + BAR_LDS))[0] = 0u; ((volatile LAS unsigned*)(lds + BAR_LDS))[1] = 0u;
        const Params P = getP(kp); (void)xb_add(&((unsigned*)(P.ws + WS_BAR))[XB_XCNT(xb_xcc_id())], 1u); }
    __syncthreads();

#pragma unroll 1
    for (int layer = 0; layer < 2; ++layer) {
        PH(phase_prep(P, lds, layer, gw, NGW, wave, lane); phase_rms(P, layer, 0, T_ALL, gw, NGW, lane));
        if (layer == 0) grid.sync(); else GSYNC();
        {   const Params P = getP(kp); pg8::Gemm g; g.A = full_ptr(P, F_H); g.Bt = (const bf16_t*)(P.ws + WS_WIN); g.A2 = g.A; g.Bt2 = g.Bt; g.M = opq(T_ALL); g.N = opq(NP1); g.K = opq(DM);
            pg8::PanelGroupOrder S; S.init(g.M, opq(G), opq(blockIdx.x));
            EpiPart1 E; E.full = full_ptr(P, 0); E.et = (bf16_t*)(P.ws + WS_ET); E.lbf = P.lb_fwd; E.lbb = P.lb_bwd; E.layer = layer;
            pg8::gemm_phase(lds, g, S, E); }
        GSYNC();
        PH(phase_scan(P, lds, tid));
        GSYNC();
#pragma unroll 1
        for (int pass = 0; pass < NPASS; ++pass) {
            const int tok0 = pass == 0 ? PASS_TOK0 : PASS_TOK1;
            const int Tp = pass == 0 ? (PASS_TOK1 - PASS_TOK0) : (T_ALL - PASS_TOK1);
            {   const Params P = getP(kp); pg8::Gemm g; g.A = full_ptr(P, F_H) + (size_t)tok0 * DM; g.Bt = (const bf16_t*)(P.ws + WS_WIN) + (size_t)NP1 * DM; g.A2 = g.A; g.Bt2 = g.Bt; g.M = opq(Tp); g.N = opq(NP2); g.K = opq(DM);
                pg8::StaticOrder S; S.init(g.M, g.N, opq(G), opq(blockIdx.x));
                EpiPart2 E; E.arr = pass_ptr(P, 0);
                pg8::gemm_phase(lds, g, S, E); }
            GSYNC();
            PH(phase_combine(P, layer, tok0, Tp, gw, NGW, lane));
            GSYNC();
            {   const Params P = getP(kp); pg8::Gemm g; g.A = pass_ptr(P, S_SZA); g.A2 = pass_ptr(P, S_M); g.Bt = (const bf16_t*)(P.ws + WS_WA); g.Bt2 = (const bf16_t*)(P.ws + WS_WB); g.M = opq(Tp); g.N = opq(DM); g.K = opq(DM);
                pg8::SplitOrder S; S.init(g.M, g.N, opq(G), opq(blockIdx.x));
                EpiMerge E; E.sga = pass_ptr(P, S_SGA); E.sgb = pass_ptr(P, S_SGB); E.outp = pass_ptr(P, S_U);
                pg8::gemm_phase(lds, g, S, E); }
            GSYNC();
            {   const Params P = getP(kp); pg8::Gemm g; g.A = pass_ptr(P, S_U); g.Bt = (const bf16_t*)(P.ws + WS_WO); g.A2 = g.A; g.Bt2 = g.Bt; g.M = opq(Tp); g.N = opq(DM); g.K = opq(DM);
                pg8::StaticOrder S; S.init(g.M, g.N, opq(G), opq(blockIdx.x));
                EpiOut E; E.xp = P.xp; E.xs = P.xs; E.out = P.out; E.layer = layer; E.tok0 = tok0;
                pg8::gemm_phase(lds, g, S, E); }
            GSYNC();
        }
    }
    PH(phase_final(P, gw, NGW, lane));
}

extern "C" void kernel_launch(void* const* d_in, const int* in_sizes, int n_in, void* d_out, int out_size, void* d_ws, size_t ws_size, hipStream_t stream) {
    static int grid_blocks = 0;
    if (grid_blocks == 0) {
        if (n_in != 13 || out_size != T_ALL * DM || ws_size < WS_TOTAL) { fprintf(stderr, "kernel_launch: unexpected shapes (n_in %d out %d ws %zu need %zu)\n", n_in, out_size, ws_size, (size_t)WS_END); grid_blocks = -1; return; }
        int dev = 0, cus = 0, per_cu = 0;
        hipGetDevice(&dev);
        hipDeviceGetAttribute(&cus, hipDeviceAttributeMultiprocessorCount, dev);
        if (hipFuncSetAttribute((const void*)mega_fwd, hipFuncAttributeMaxDynamicSharedMemorySize, LDS_BYTES) != hipSuccess) { fprintf(stderr, "hipFuncSetAttribute failed\n"); grid_blocks = -1; return; }
        hipOccupancyMaxActiveBlocksPerMultiprocessor(&per_cu, (const void*)mega_fwd, 512, LDS_BYTES);
        if (per_cu < 1) per_cu = 1;
        grid_blocks = cus * per_cu;
        (void)hipGetLastError();
    }
    if (grid_blocks < 0) return;
    Params p{};
    p.xp = (const float*)d_in[0]; p.xs = (const float*)d_in[1]; p.norm_g = (const float*)d_in[2]; p.w_in = (const float*)d_in[3];
    p.lb_fwd = (const float*)d_in[4]; p.lb_bwd = (const float*)d_in[5]; p.hnorm_g = (const float*)d_in[6]; p.conv_w = (const float*)d_in[7];
    p.conv_b = (const float*)d_in[8]; p.w_a = (const float*)d_in[9]; p.w_b = (const float*)d_in[10]; p.w_o = (const float*)d_in[11]; p.final_g = (const float*)d_in[12];
    p.out = (float*)d_out; p.ws = (unsigned char*)d_ws;
    if (hipMemsetAsync((char*)d_ws + WS_BAR, 0, XCD_BAR_WORDS * 4, stream) != hipSuccess) { fprintf(stderr, "memset of barrier words failed\n"); return; }
    void* args[] = {&p};
    hipError_t e = hipLaunchCooperativeKernel((const void*)mega_fwd, dim3(grid_blocks), dim3(512), args, LDS_BYTES, stream);
    if (e != hipSuccess) fprintf(stderr, "cooperative launch failed: %s (grid %d)\n", hipGetErrorString(e), grid_blocks);
}
```

```cpp
#include <hip/hip_runtime.h>
#include <hip/hip_cooperative_groups.h>
#include <cstdio>
namespace cg = cooperative_groups;

#define LAS __attribute__((address_space(3)))
typedef unsigned short bf16_t;
typedef short bf16x8 __attribute__((ext_vector_type(8)));
typedef float f32x4 __attribute__((ext_vector_type(4)));
typedef float f32x16 __attribute__((ext_vector_type(16)));
typedef unsigned u32x4 __attribute__((ext_vector_type(4)));
typedef unsigned u32x2 __attribute__((ext_vector_type(2)));

constexpr int DM = 1024;
constexpr int NPROJ = 11264;
constexpr int T_PROMPT = 16384;
constexpr int T_ALL = 81920;
constexpr int NPASS = 2;
constexpr int PASS_TOK0 = 0, PASS_TOK1 = 32768;
constexpr int TP_MAX = 49152;
constexpr float EPS = 1e-6f;
constexpr float LOG2E = 1.4426950408889634f;

constexpr size_t AB = (size_t)T_ALL * DM * 2;
constexpr size_t PB = (size_t)TP_MAX * DM * 2;
enum { F_QF = 0, F_QB, F_KF, F_KB, F_I, F_H };
enum { S_SZA = 0, S_U, S_M, S_SGA, S_SGB };
constexpr size_t WS_FULL = 0;
constexpr size_t WS_PASS = 2 * AB;
constexpr size_t WS_WIN = 6 * AB;
constexpr int NP1 = 4096, NP2 = 7168, NWIN = NP1 + NP2;
constexpr size_t WS_WA = WS_WIN + (size_t)NWIN * DM * 2;
constexpr size_t WS_WB = WS_WA + (size_t)DM * DM * 2;
constexpr size_t WS_WO = WS_WB + (size_t)DM * DM * 2;
constexpr size_t WS_ET = WS_WO + (size_t)DM * DM * 2;
constexpr int NCHUNK = T_ALL / 64;
constexpr size_t WS_END = WS_ET + (size_t)2 * NCHUNK * 2 * DM * 2;
static_assert(5 * PB <= 3 * AB, "per-pass arrays must fit the dead scan inputs");

constexpr size_t WS_BAR = WS_END;
constexpr size_t WS_TOTAL = WS_BAR + 3456 * 4;
constexpr int BAR_LDS = 131072;
constexpr int LDS_BYTES = 137216;

struct Params {
    const float* xp; const float* xs; const float* norm_g; const float* w_in; const float* lb_fwd; const float* lb_bwd;
    const float* hnorm_g; const float* conv_w; const float* conv_b; const float* w_a; const float* w_b; const float* w_o; const float* final_g;
    float* out; unsigned char* ws;
};

__device__ __forceinline__ unsigned cvt_pk_bf16(float lo, float hi) { unsigned r; asm volatile("v_cvt_pk_bf16_f32 %0, %1, %2" : "=v"(r) : "v"(lo), "v"(hi)); return r; }
__device__ __forceinline__ float bf_lo(unsigned w) { return __uint_as_float(w << 16); }
__device__ __forceinline__ float bf_hi(unsigned w) { return __uint_as_float(w & 0xffff0000u); }
__device__ __forceinline__ float fsigmoid(float x) { return __builtin_amdgcn_rcpf(1.0f + __builtin_amdgcn_exp2f(-x * LOG2E)); }
__device__ __forceinline__ float wave_sum(float v) {
#pragma unroll
    for (int o = 1; o < 64; o <<= 1) v += __shfl_xor(v, o);
    return v;
}
namespace pg8 {
constexpr int BM = 256, BK = 64, HALF = 128, HTB = HALF * BK * 2, STAGE_BYTES = 8 * HTB, NXCD = 8, WGM = 8;
__device__ __forceinline__ int lds_byte(int r, int c) { const int st = (r >> 4) * 2 + (c >> 5), rr = r & 15, cc = c & 31, ob = rr * 64 + cc * 2; return st * 1024 + (ob ^ (((ob >> 9) & 1) << 5)); }
__device__ __forceinline__ void stage_rc(int b, int& R, int& C) { const int st = b / 1024, sb = b % 1024, swz = sb ^ (((sb >> 9) & 1) << 5); R = (st >> 1) * 16 + swz / 64; C = (st & 1) * 32 + (swz % 64) / 2; }
__device__ __forceinline__ int perm32(int rho) { const int n = rho >> 4, i = rho & 15; return 8 * (i >> 2) + 4 * n + (i & 3); }

struct Unit { int pm, pn, kh; };
struct Gemm { const bf16_t* A; const bf16_t* Bt; const bf16_t* A2; const bf16_t* Bt2; int M, N, K; };

struct StaticOrder {
    int nM, nN, nwg, G, c;
    __device__ void init(int M, int N, int G_, int c_) { nM = M / BM; nN = N / BM; nwg = nM * nN; G = G_; c = c_; }
    __device__ bool next(int i, Unit& u) const {
        const long L = (long)i * G + c; if (L >= nwg) return false;
        int wgid = (int)L; { const int q = nwg / NXCD, r = nwg % NXCD, xcd = wgid % NXCD, off = wgid / NXCD; wgid = (xcd < r ? xcd * (q + 1) : r * (q + 1) + (xcd - r) * q) + off; }
        const int nig = WGM * nN, gid = wgid / nig, fm = gid * WGM, gsz = (nM - fm) < WGM ? (nM - fm) : WGM;
        u.pm = fm + ((wgid % nig) % gsz); u.pn = (wgid % nig) / gsz; u.kh = 0; return true;
    }
};

struct SplitOrder : StaticOrder {
    __device__ bool next(int i, Unit& u) const { const bool ok = StaticOrder::next(i >> 1, u); u.kh = i & 1; return ok; }
};

struct PanelGroupOrder {
    int ngroups, G, c;
    __device__ void init(int M, int G_, int c_) { ngroups = (M / BM) * 4; G = G_; c = c_; }
    __device__ bool next(int i, Unit& u) const {
        const int gi = i >> 2, sub = i & 3;
        int L;
        if (G == 256 && (ngroups & 7) == 0) { const int per = ngroups >> 3, x = c & 7, idx = c >> 3; const int off = idx + 32 * gi; if (off >= per) return false; L = x * per + off; }
        else { L = gi * G + c; if (L >= ngroups) return false; }
        const int j = L & 3;
        u.pm = L >> 2; u.pn = sub == 0 ? 2 * j : (sub == 1 ? 2 * j + 1 : (sub == 2 ? 8 + j : 12 + j)); u.kh = 0; return true;
    }
};

template <class Epi, class Sched>
__device__ __forceinline__ void gemm_phase(LAS unsigned char* lds, const Gemm g, const Sched& S, const Epi& E) {
    int tid_ = threadIdx.x; asm volatile("" : "+v"(tid_));
    const int tid = tid_, wid = __builtin_amdgcn_readfirstlane(tid >> 6), lane = tid & 63, wr = wid >> 2, wc = wid & 3, fr = lane & 15, fq = lane >> 4;
    const int K = g.K, nt = K / BK;
    unsigned voffA[2], voffB[2];
#pragma unroll
    for (int i = 0; i < 2; ++i) { int R, C; stage_rc(tid * 16 + i * 8192, R, C); const int Rb = Epi::PERM ? ((R & ~31) + perm32(R & 31)) : R;
        voffA[i] = (unsigned)(R * K + C) * 2u; voffB[i] = (unsigned)(Rb * K + C) * 2u; }
    const size_t kstep = (size_t)(BK * 2);
    const size_t hstep = (size_t)HALF * K * 2;
    const size_t tstep = 2 * hstep;
    const unsigned ldsw = (unsigned)wid * 1024u;
    const int aoff = lds_byte(wr * 64 + fr, fq * 8), boff = lds_byte(wc * 32 + fr, fq * 8);
#define PG8_SA(b, h) (((b) * 2 + (h)) * HTB)
#define PG8_SB(b, h) ((4 + (b) * 2 + (h)) * HTB)
#define PG8_STAGE(bufoff, gbase, voff) do { _Pragma("unroll") for (int _i = 0; _i < 2; ++_i) \
        __builtin_amdgcn_global_load_lds((const unsigned*)((const char*)(gbase) + (voff)[_i]), (LAS unsigned*)(lds + (bufoff) + ldsw + _i * 8192), 16, 0, 0); } while (0)
#define PG8_LDA(dst, b, h) do { _Pragma("unroll") for (int m = 0; m < 4; ++m) _Pragma("unroll") for (int k = 0; k < 2; ++k) dst[m][k] = *(const LAS bf16x8*)(lds + PG8_SA(b, h) + aoff + m * 2048 + k * 1024); } while (0)
#define PG8_LDB(dst, b, h) do { _Pragma("unroll") for (int n = 0; n < 2; ++n) _Pragma("unroll") for (int k = 0; k < 2; ++k) dst[n][k] = *(const LAS bf16x8*)(lds + PG8_SB(b, h) + boff + n * 2048 + k * 1024); } while (0)
#define PG8_MMA(ai, bj, At, Bt) do { __builtin_amdgcn_s_setprio(1); _Pragma("unroll") for (int m = 0; m < 4; ++m) _Pragma("unroll") for (int n = 0; n < 2; ++n) _Pragma("unroll") for (int k = 0; k < 2; ++k) \
        acc[ai][bj][m][n] = __builtin_amdgcn_mfma_f32_16x16x32_bf16(Bt[n][k], At[m][k], acc[ai][bj][m][n], 0, 0, 0); __builtin_amdgcn_s_setprio(0); } while (0)
#define PG8_WAIT_V(n) asm volatile("s_waitcnt vmcnt(" #n ")" ::: "memory")
#define PG8_WAIT_L(n) asm volatile("s_waitcnt lgkmcnt(" #n ")" ::: "memory")
#define PG8_BAR __builtin_amdgcn_s_barrier()
#define PG8_SCHED __builtin_amdgcn_sched_barrier(0)
    Unit cur, nxt; int ui = 0;
    if (!S.next(0, cur)) return;
    f32x4 acc[2][2][4][2];
#pragma unroll
    for (int a = 0; a < 2; ++a)
#pragma unroll
        for (int b = 0; b < 2; ++b)
#pragma unroll
            for (int m = 0; m < 4; ++m)
#pragma unroll
                for (int n = 0; n < 2; ++n) acc[a][b][m][n] = (f32x4){0.f, 0.f, 0.f, 0.f};
    bf16x8 At[4][2], B0[2][2], B1[2][2];
    const char* cA = (const char*)((Epi::SPLITK && cur.kh) ? g.A2 : g.A) + (size_t)cur.pm * tstep; const char* cB = (const char*)((Epi::SPLITK && cur.kh) ? g.Bt2 : g.Bt) + (size_t)cur.pn * tstep;
    PG8_STAGE(PG8_SB(0, 0), cB, voffB); PG8_STAGE(PG8_SA(0, 0), cA, voffA); PG8_STAGE(PG8_SB(0, 1), cB + hstep, voffB); PG8_STAGE(PG8_SA(0, 1), cA + hstep, voffA);
    if (wr == 1) PG8_BAR;
    PG8_WAIT_V(4); PG8_BAR;
    PG8_STAGE(PG8_SB(1, 0), cB + kstep, voffB); PG8_STAGE(PG8_SA(1, 0), cA + kstep, voffA); PG8_STAGE(PG8_SB(1, 1), cB + hstep + kstep, voffB);
    PG8_WAIT_V(6); PG8_BAR;
    for (;;) {
        const bool has_next = S.next(ui + 1, nxt);
        const char* nA = has_next ? (const char*)((Epi::SPLITK && nxt.kh) ? g.A2 : g.A) + (size_t)nxt.pm * tstep : cA; const char* nB = has_next ? (const char*)((Epi::SPLITK && nxt.kh) ? g.Bt2 : g.Bt) + (size_t)nxt.pn * tstep : cB;
        for (int t = 0; t < nt; t += 2) {
            const bool last = (t == nt - 2);
            const char* a1 = cA + (size_t)(t + 1) * kstep;
            const char* a2 = last ? nA : cA + (size_t)(t + 2) * kstep; const char* b2 = last ? nB : cB + (size_t)(t + 2) * kstep;
            const char* a3 = a2 + kstep; const char* b3 = b2 + kstep;
            PG8_LDB(B0, 0, 0); PG8_SCHED; PG8_LDA(At, 0, 0); PG8_STAGE(PG8_SA(1, 1), a1 + hstep, voffA);
            PG8_WAIT_L(8); PG8_BAR; PG8_WAIT_L(0); PG8_MMA(0, 0, At, B0); PG8_BAR; PG8_SCHED;
            PG8_LDB(B1, 0, 1); PG8_STAGE(PG8_SB(0, 0), b2, voffB);
            PG8_BAR; PG8_WAIT_L(0); PG8_MMA(0, 1, At, B1); PG8_BAR;
            PG8_LDA(At, 0, 1); PG8_STAGE(PG8_SA(0, 0), a2, voffA);
            PG8_BAR; PG8_WAIT_L(0); PG8_MMA(1, 0, At, B0); PG8_BAR; PG8_SCHED;
            PG8_STAGE(PG8_SB(0, 1), b2 + hstep, voffB);
            PG8_WAIT_V(6); PG8_BAR; PG8_MMA(1, 1, At, B1); PG8_BAR;
            PG8_LDB(B0, 1, 0); PG8_SCHED; PG8_LDA(At, 1, 0); PG8_STAGE(PG8_SA(0, 1), a2 + hstep, voffA);
            PG8_WAIT_L(8); PG8_BAR; PG8_WAIT_L(0); PG8_MMA(0, 0, At, B0); PG8_BAR; PG8_SCHED;
            PG8_LDB(B1, 1, 1); PG8_STAGE(PG8_SB(1, 0), b3, voffB);
            PG8_BAR; PG8_WAIT_L(0); PG8_MMA(0, 1, At, B1); PG8_BAR;
            PG8_LDA(At, 1, 1); PG8_STAGE(PG8_SA(1, 0), a3, voffA);
            PG8_BAR; PG8_WAIT_L(0); PG8_MMA(1, 0, At, B0); PG8_BAR; PG8_SCHED;
            PG8_STAGE(PG8_SB(1, 1), b3 + hstep, voffB);
            PG8_WAIT_V(6); PG8_BAR; PG8_MMA(1, 1, At, B1); PG8_BAR;
        }
        bool keep = false;
        if constexpr (Epi::SPLITK) { if (cur.kh == 0) { E.mid(acc, cur, wr, wc, fr, fq); keep = true; } else E(acc, cur, wr, wc, fr, fq); }
        else E(acc, cur, wr, wc, fr, fq);
        if (!has_next) break;
        if (!keep)
#pragma unroll
        for (int a = 0; a < 2; ++a)
#pragma unroll
            for (int b = 0; b < 2; ++b)
#pragma unroll
                for (int m = 0; m < 4; ++m)
#pragma unroll
                    for (int n = 0; n < 2; ++n) acc[a][b][m][n] = (f32x4){0.f, 0.f, 0.f, 0.f};
        cur = nxt; cA = nA; cB = nB; ++ui;
    }
    PG8_WAIT_V(0);
    if (wr == 0) PG8_BAR;
    PG8_BAR;
#undef PG8_SA
#undef PG8_SB
#undef PG8_STAGE
#undef PG8_LDA
#undef PG8_LDB
#undef PG8_MMA
#undef PG8_WAIT_V
#undef PG8_WAIT_L
#undef PG8_BAR
#undef PG8_SCHED
}
}
using pg8::Unit;
using pg8::HALF;
typedef float f32x2 __attribute__((ext_vector_type(2)));
typedef __bf16 bf16x2_t __attribute__((ext_vector_type(2)));
__device__ __forceinline__ unsigned pkbf(float a, float b) { f32x2 v = {a, b}; bf16x2_t r = __builtin_convertvector(v, bf16x2_t); return __builtin_bit_cast(unsigned, r); }

__host__ __device__ __forceinline__ int inproj_src_col(int r) {
    if (r < NP1) {
        const int tile = r >> 8, w = r & 255, half = w >> 7, c = w & 127;
        if (tile < 8) return (half == 0 ? 1024 : 2048) + 128 * tile + c;
        if (tile < 12) return r - 2048;
        return r;
    }
    const int r2 = r - NP1, tile = r2 >> 8, w = r2 & 255, half = w >> 7, c = w & 127;
    if (tile < 4) return 4096 + r2;
    if (tile < 12) return (half == 0 ? 6 * 1024 : 7 * 1024) + 128 * (tile - 4) + c;
    if (tile < 20) return (half == 0 ? 5 * 1024 : 8 * 1024) + 128 * (tile - 12) + c;
    if (tile < 24) return 9 * 1024 + (r2 - 20 * 256);
    return 10 * 1024 + (r2 - 24 * 256);
}

template <int CTRL> __device__ __forceinline__ float dppf(float x) { return __builtin_bit_cast(float, __builtin_amdgcn_update_dpp(0, __builtin_bit_cast(int, x), CTRL, 0xf, 0xf, true)); }
__device__ __forceinline__ float scan16_up(float x) { x += dppf<0x111>(x); x += dppf<0x112>(x); x += dppf<0x114>(x); x += dppf<0x118>(x); return x; }
__device__ __forceinline__ float scan16_dn(float x) { x += dppf<0x101>(x); x += dppf<0x102>(x); x += dppf<0x104>(x); x += dppf<0x108>(x); return x; }

struct EpiPart1 {
    static constexpr bool PERM = true, SPLITK = false;
    bf16_t* full; bf16_t* et; const float* lbf; const float* lbb; int layer;
    __device__ __forceinline__ void operator()(const f32x4 (&acc)[2][2][4][2], const Unit& u, int wr, int wc, int fr_in, int fq_in) const {
        int ln_ = threadIdx.x & 63; asm volatile("" : "+v"(ln_)); const int fr = ln_ & 15, fq = ln_ >> 4; (void)fr_in; (void)fq_in;
        const int tile = u.pn;
        const int row0 = u.pm * 256 + wr * 64 + fr;
        if (tile >= 12) {
            bf16_t* base = full + (size_t)F_I * ((size_t)T_ALL * DM) + (tile - 12) * 256 + wc * 32 + 8 * fq;
#pragma unroll
            for (int ai = 0; ai < 2; ++ai)
#pragma unroll
                for (int m = 0; m < 4; ++m)
#pragma unroll
                    for (int bj = 0; bj < 2; ++bj) {
                        u32x4 w; w.x = pkbf(acc[ai][bj][m][0][0], acc[ai][bj][m][0][1]); w.y = pkbf(acc[ai][bj][m][0][2], acc[ai][bj][m][0][3]);
                        w.z = pkbf(acc[ai][bj][m][1][0], acc[ai][bj][m][1][1]); w.w = pkbf(acc[ai][bj][m][1][2], acc[ai][bj][m][1][3]);
                        *(u32x4*)(base + (size_t)(row0 + ai * HALF + m * 16) * DM + bj * HALF) = w;
                    }
            return;
        }
        if (tile >= 8) {
            const int col0 = (tile - 8) * 256 + wc * 32 + 8 * fq;
            bf16_t* qf = full + (size_t)F_QF * ((size_t)T_ALL * DM) + col0;
            bf16_t* qb = full + (size_t)F_QB * ((size_t)T_ALL * DM) + col0;
#define QPASS(qx) { u32x4 cf[2], nf[2]; \
                _Pragma("unroll") for (int bj = 0; bj < 2; ++bj) cf[bj] = *(const u32x4*)((qx) + (size_t)row0 * DM + bj * HALF); \
                _Pragma("unroll") for (int g = 0; g < 8; ++g) { \
                    const int ai = g >> 2, m = g & 3; \
                    const size_t ro = (size_t)(row0 + ai * HALF + m * 16) * DM; \
                    if (g < 7) { const size_t rn = (size_t)(row0 + ((g + 1) >> 2) * HALF + ((g + 1) & 3) * 16) * DM; \
                        _Pragma("unroll") for (int bj = 0; bj < 2; ++bj) nf[bj] = *(const u32x4*)((qx) + rn + bj * HALF); } \
                    _Pragma("unroll") for (int bj = 0; bj < 2; ++bj) { \
                        const unsigned fw[4] = {cf[bj].x, cf[bj].y, cf[bj].z, cf[bj].w}; \
                        unsigned wf[4]; \
                        _Pragma("unroll") for (int q = 0; q < 4; ++q) \
                            wf[q] = pkbf(acc[ai][bj][m][q >> 1][2 * (q & 1)] * (0.08838834764831845f * bf_lo(fw[q])), acc[ai][bj][m][q >> 1][2 * (q & 1) + 1] * (0.08838834764831845f * bf_hi(fw[q]))); \
                        u32x4 o; o.x = wf[0]; o.y = wf[1]; o.z = wf[2]; o.w = wf[3]; \
                        *(u32x4*)((qx) + ro + bj * HALF) = o; } \
                    _Pragma("unroll") for (int bj = 0; bj < 2; ++bj) cf[bj] = nf[bj]; } \
                asm volatile("" ::: "memory"); }
            QPASS(qf)
            __builtin_amdgcn_sched_barrier(0);
            QPASS(qb)
#undef QPASS
            return;
        }
        const int head = tile;
        const int colh = head * 128 + wc * 32 + 8 * fq;
        if (true) { f_body<0>(acc, u, wr, fr, colh, row0); __builtin_amdgcn_sched_barrier(0); f_body<1>(acc, u, wr, fr, colh, row0); }
    }
    template <int dirb>
    __device__ __forceinline__ void f_body(const f32x4 (&acc)[2][2][4][2], const Unit& u, int wr, int fr, int colh, int row0) const {
        bf16_t* egp = full + (size_t)(dirb ? F_QB : F_QF) * ((size_t)T_ALL * DM) + colh;
        bf16_t* kd = full + (size_t)(dirb ? F_KB : F_KF) * ((size_t)T_ALL * DM) + colh;
        const float* raw = dirb ? lbb : lbf;
        const float lbsel = layer == 0 ? 0.f : 1.f;
#pragma unroll
        for (int ai = 0; ai < 2; ++ai) {
            const int chunk = (u.pm * 256 + ai * HALF + wr * 64) >> 6;
            bf16_t* ep = et + (((size_t)dirb * NCHUNK + chunk) * 2) * DM + colh;
            unsigned oqp[4][4], okp[4][4], e0p[4], e1p[4];
#pragma unroll
            for (int c2 = 0; c2 < 4; ++c2) {
                float oq[2][4], ok[2][4], e0[2], e1[2];
#pragma unroll
                for (int h = 0; h < 2; ++h) {
                    const int c = 2 * c2 + h, n = c >> 2, jj = c & 3;
                    const float r0 = raw[colh + c], r1 = raw[DM + colh + c];
                    const float lb = lbsel * __builtin_amdgcn_rcpf(1.0f + __builtin_amdgcn_exp2f((r0 - r1) * LOG2E));
                    float l[4], kk[4], p[4], t[4], g[4];
#pragma unroll
                    for (int m = 0; m < 4; ++m) { const float a = acc[ai][dirb][m][n][jj]; const float sg = fsigmoid(a); const float f = lb + (1.0f - lb) * sg;
                        l[m] = __builtin_amdgcn_logf(fmaxf(f, 1e-20f)); kk[m] = (1.0f - lb) * (1.0f - sg); }
                    float tfirst, tsecond;
                    if (!dirb) {
#pragma unroll
                        for (int m = 0; m < 4; ++m) { p[m] = scan16_up(l[m]); t[m] = __shfl(p[m], 15, 16); }
                        g[0] = p[0]; g[1] = p[1] + t[0]; g[2] = p[2]; g[3] = p[3] + t[2]; tfirst = t[0] + t[1]; tsecond = t[2] + t[3];
                    } else {
#pragma unroll
                        for (int m = 0; m < 4; ++m) { p[m] = scan16_dn(l[m]); t[m] = __shfl(p[m], 0, 16); }
                        g[3] = p[3]; g[2] = p[2] + t[3]; g[1] = p[1]; g[0] = p[0] + t[1]; tfirst = t[2] + t[3]; tsecond = t[0] + t[1];
                    }
                    e0[h] = __builtin_amdgcn_exp2f(tfirst); e1[h] = __builtin_amdgcn_exp2f(tsecond);
#pragma unroll
                    for (int m = 0; m < 4; ++m) { const float gc = fmaxf(g[m], -100.f - dirb);
                        oq[h][m] = __builtin_amdgcn_exp2f(gc); ok[h][m] = kk[m] * __builtin_amdgcn_exp2f(-gc); }
                    __builtin_amdgcn_sched_barrier(0);
                }
#pragma unroll
                for (int m = 0; m < 4; ++m) { oqp[m][c2] = pkbf(oq[0][m], oq[1][m]); okp[m][c2] = pkbf(ok[0][m], ok[1][m]); }
                e0p[c2] = pkbf(e0[0], e0[1]); e1p[c2] = pkbf(e1[0], e1[1]);
            }
#pragma unroll
            for (int m = 0; m < 4; ++m) {
                const size_t ro = (size_t)(row0 + ai * HALF + m * 16) * DM;
                u32x4 w; w.x = oqp[m][0]; w.y = oqp[m][1]; w.z = oqp[m][2]; w.w = oqp[m][3];
                *(u32x4*)(egp + ro) = w;
                w.x = okp[m][0]; w.y = okp[m][1]; w.z = okp[m][2]; w.w = okp[m][3];
                *(u32x4*)(kd + ro) = w;
            }
            {
                u32x4 w; w.x = e0p[0]; w.y = e0p[1]; w.z = e0p[2]; w.w = e0p[3];
                *(u32x4*)(ep) = w;
                w.x = e1p[0]; w.y = e1p[1]; w.z = e1p[2]; w.w = e1p[3];
                *(u32x4*)(ep + DM) = w; }
            asm volatile("" ::: "memory");
        }
    }
};

struct EpiPart2 {
    static constexpr bool PERM = true, SPLITK = false;
    bf16_t* arr;
    __device__ __forceinline__ void operator()(const f32x4 (&acc)[2][2][4][2], const Unit& u, int wr, int wc, int fr_in, int fq_in) const {
        int fr = fr_in, fq = fq_in; asm volatile("" : "+v"(fr), "+v"(fq));
        const int tile = u.pn;
        const int row0 = u.pm * 256 + wr * 64 + fr;
        if (tile >= 4 && tile < 20) {
            const bool isU = tile < 12;
            bf16_t* base = arr + (size_t)(isU ? S_U : S_M) * ((size_t)TP_MAX * DM) + (isU ? (tile - 4) : (tile - 12)) * 128 + wc * 32 + 8 * fq;
#pragma unroll
            for (int ai = 0; ai < 2; ++ai)
#pragma unroll
                for (int m = 0; m < 4; ++m) {
                    float o[8];
#pragma unroll
                    for (int n = 0; n < 2; ++n)
#pragma unroll
                        for (int j = 0; j < 4; ++j) { const float a = acc[ai][0][m][n][j], b = acc[ai][1][m][n][j];
                            o[4 * n + j] = isU ? a * b : a * (b * fsigmoid(b)); }
                    u32x4 w; w.x = pkbf(o[0], o[1]); w.y = pkbf(o[2], o[3]); w.z = pkbf(o[4], o[5]); w.w = pkbf(o[6], o[7]);
                    *(u32x4*)(base + (size_t)(row0 + ai * HALF + m * 16) * DM) = w;
                }
            return;
        }
        const bool silu = tile < 4;
        const int aidx = tile < 4 ? S_SZA : (tile < 24 ? S_SGA : S_SGB);
        bf16_t* base = arr + (size_t)aidx * ((size_t)TP_MAX * DM) + (tile & 3) * 256 + wc * 32 + 8 * fq;
#pragma unroll
        for (int ai = 0; ai < 2; ++ai)
#pragma unroll
            for (int m = 0; m < 4; ++m)
#pragma unroll
                for (int bj = 0; bj < 2; ++bj) {
                    float o[8];
#pragma unroll
                    for (int n = 0; n < 2; ++n)
#pragma unroll
                        for (int j = 0; j < 4; ++j) { const float a = acc[ai][bj][m][n][j]; const float s = fsigmoid(a); o[4 * n + j] = silu ? a * s : s; }
                    u32x4 w; w.x = pkbf(o[0], o[1]); w.y = pkbf(o[2], o[3]); w.z = pkbf(o[4], o[5]); w.w = pkbf(o[6], o[7]);
                    *(u32x4*)(base + (size_t)(row0 + ai * HALF + m * 16) * DM + bj * HALF) = w;
                }
    }
};

struct EpiMerge {
    static constexpr bool PERM = true, SPLITK = true;
    const bf16_t* sga; const bf16_t* sgb; bf16_t* outp;
    __device__ __forceinline__ void mid(f32x4 (&acc)[2][2][4][2], const Unit& u, int wr, int wc, int fr_in, int fq_in) const {
        int fr = fr_in, fq = fq_in; asm volatile("" : "+v"(fr), "+v"(fq));
        const int row0 = u.pm * 256 + wr * 64 + fr, col0 = u.pn * 256 + wc * 32 + 8 * fq;
#pragma unroll
        for (int ai = 0; ai < 2; ++ai)
#pragma unroll
            for (int m = 0; m < 4; ++m) {
                asm volatile("" ::: "memory");
#pragma unroll
                for (int bj = 0; bj < 2; ++bj) {
                    const size_t off = (size_t)(row0 + ai * HALF + m * 16) * DM + col0 + bj * HALF;
                    const u32x4 a = *(const u32x4*)(sga + off), b = *(const u32x4*)(sgb + off);
                    const unsigned aw[4] = {a.x, a.y, a.z, a.w}, bw[4] = {b.x, b.y, b.z, b.w};
#pragma unroll
                    for (int q = 0; q < 4; ++q) {
                        const float r0 = bf_lo(aw[q]) * __builtin_amdgcn_rcpf(fmaxf(bf_lo(bw[q]), 1e-30f));
                        const float r1 = bf_hi(aw[q]) * __builtin_amdgcn_rcpf(fmaxf(bf_hi(bw[q]), 1e-30f));
                        acc[ai][bj][m][q >> 1][2 * (q & 1)] *= r0; acc[ai][bj][m][q >> 1][2 * (q & 1) + 1] *= r1;
                    }
                }
                asm volatile("" : "+v"(acc[ai][0][m][0]), "+v"(acc[ai][0][m][1]), "+v"(acc[ai][1][m][0]), "+v"(acc[ai][1][m][1]));
            }
    }
    __device__ __forceinline__ void operator()(const f32x4 (&acc)[2][2][4][2], const Unit& u, int wr, int wc, int fr_in, int fq_in) const {
        int fr = fr_in, fq = fq_in; asm volatile("" : "+v"(fr), "+v"(fq));
        const int row0 = u.pm * 256 + wr * 64 + fr, col0 = u.pn * 256 + wc * 32 + 8 * fq;
        u32x4 cur[2], nxt[2];
#pragma unroll
        for (int bj = 0; bj < 2; ++bj) cur[bj] = *(const u32x4*)(sgb + (size_t)row0 * DM + col0 + bj * HALF);
#pragma unroll
        for (int g = 0; g < 8; ++g) {
            const int ai = g >> 2, m = g & 3;
            const size_t ro = (size_t)(row0 + ai * HALF + m * 16) * DM + col0;
            if (g < 7) { const int ai2 = (g + 1) >> 2, m2 = (g + 1) & 3; const size_t rn = (size_t)(row0 + ai2 * HALF + m2 * 16) * DM + col0;
#pragma unroll
                for (int bj = 0; bj < 2; ++bj) nxt[bj] = *(const u32x4*)(sgb + rn + bj * HALF); }
#pragma unroll
            for (int bj = 0; bj < 2; ++bj) {
                const unsigned bw[4] = {cur[bj].x, cur[bj].y, cur[bj].z, cur[bj].w};
                unsigned w[4];
#pragma unroll
                for (int q = 0; q < 4; ++q) {
                    const float s0 = fmaxf(bf_lo(bw[q]), 1e-30f), s1 = fmaxf(bf_hi(bw[q]), 1e-30f);
                    w[q] = pkbf(acc[ai][bj][m][q >> 1][2 * (q & 1)] * s0, acc[ai][bj][m][q >> 1][2 * (q & 1) + 1] * s1);
                }
                u32x4 ov; ov.x = w[0]; ov.y = w[1]; ov.z = w[2]; ov.w = w[3];
                *(u32x4*)(outp + ro + bj * HALF) = ov;
            }
#pragma unroll
            for (int bj = 0; bj < 2; ++bj) cur[bj] = nxt[bj];
        }
    }
};

struct EpiOut {
    static constexpr bool PERM = false, SPLITK = false;
    const float* xp; const float* xs; float* out; int layer; int tok0;
    __device__ __forceinline__ void operator()(const f32x4 (&acc)[2][2][4][2], const Unit& u, int wr, int wc, int fr_in, int fq_in) const {
        int fr = fr_in, fq = fq_in; asm volatile("" : "+v"(fr), "+v"(fq));
        const int trow0 = tok0 + u.pm * 256;
        const float* res;
        if (layer == 0) res = (trow0 < T_PROMPT) ? xp + (size_t)trow0 * DM : xs + (size_t)(trow0 - T_PROMPT) * DM;
        else res = out + (size_t)trow0 * DM;
        float* o = out + (size_t)trow0 * DM;
        const int r0 = wr * 64 + fr, col0 = u.pn * 256 + wc * 32 + 4 * fq;
        f32x4 cur[4], nxt[4];
#pragma unroll
        for (int q = 0; q < 4; ++q) cur[q] = *(const f32x4*)(res + (size_t)r0 * DM + col0 + (q >> 1) * HALF + (q & 1) * 16);
#pragma unroll
        for (int g = 0; g < 8; ++g) {
            const int ai = g >> 2, m = g & 3;
            const size_t ro = (size_t)(r0 + ai * HALF + m * 16) * DM + col0;
            if (g < 7) { const int ai2 = (g + 1) >> 2, m2 = (g + 1) & 3; const size_t rn = (size_t)(r0 + ai2 * HALF + m2 * 16) * DM + col0;
#pragma unroll
                for (int q = 0; q < 4; ++q) nxt[q] = *(const f32x4*)(res + rn + (q >> 1) * HALF + (q & 1) * 16); }
#pragma unroll
            for (int q = 0; q < 4; ++q) *(f32x4*)(o + ro + (q >> 1) * HALF + (q & 1) * 16) = cur[q] + acc[ai][q >> 1][m][q & 1];
#pragma unroll
            for (int q = 0; q < 4; ++q) cur[q] = nxt[q];
        }
    }
};
__device__ __forceinline__ bf16_t* full_ptr(const Params& P, int a) { return (bf16_t*)(P.ws + WS_FULL + (size_t)a * AB); }
__device__ __forceinline__ bf16_t* pass_ptr(const Params& P, int a) { return (bf16_t*)(P.ws + WS_PASS + (size_t)a * PB); }

__device__ __forceinline__ void tr_item(const float* W, int N, int k0, int srcc0, bf16_t* dst, int dstride, LAS float* scr, int lane) {
#pragma unroll 8
    for (int i = 0; i < 32; ++i) { const int kk = 2 * i + (lane >> 5); scr[kk * 33 + (lane & 31)] = W[(size_t)(k0 + kk) * N + srcc0 + (lane & 31)]; }
    asm volatile("s_waitcnt lgkmcnt(0)" ::: "memory");
    const int c = lane & 7;
#pragma unroll
    for (int j = 0; j < 4; ++j) { const int n = (lane >> 3) + 8 * j; const LAS float* s = scr + (8 * c) * 33 + n;
        u32x4 o; o.x = cvt_pk_bf16(s[0 * 33], s[1 * 33]); o.y = cvt_pk_bf16(s[2 * 33], s[3 * 33]); o.z = cvt_pk_bf16(s[4 * 33], s[5 * 33]); o.w = cvt_pk_bf16(s[6 * 33], s[7 * 33]);
        *(u32x4*)(dst + (size_t)n * dstride + 8 * c) = o; }
    asm volatile("s_waitcnt lgkmcnt(0)" ::: "memory");
}

__device__ __forceinline__ void phase_prep(const Params& P, LAS unsigned char* lds, int layer, int gw, int NGW, int wave, int lane) {
    LAS float* scr = (LAS float*)(lds + wave * 16384);
    constexpr int I_IN = 16 * (NWIN / 32), I_SQ = 16 * 32;
    constexpr int PER_LAYER = I_IN + 3 * I_SQ;
    for (int it = gw; it < PER_LAYER; it += NGW) {
        int r = it;
        if (r < I_IN) { const int kb = r / (NWIN / 32), nb = r % (NWIN / 32); const int n0 = nb * 32;
            bf16_t* dst = (bf16_t*)(P.ws + WS_WIN) + (size_t)n0 * DM + kb * 64;
            tr_item(P.w_in + (size_t)layer * DM * NPROJ, NPROJ, kb * 64, inproj_src_col(n0), dst, DM, scr, lane); continue; }
        r -= I_IN;
        const int which = r / I_SQ; r %= I_SQ; const int kb = r / 32, nb = r % 32, n0 = nb * 32;
        if (which == 0) tr_item(P.w_a + (size_t)layer * DM * DM, DM, kb * 64, n0, (bf16_t*)(P.ws + WS_WA) + (size_t)n0 * DM + kb * 64, DM, scr, lane);
        else if (which == 1) tr_item(P.w_b + (size_t)layer * DM * DM, DM, kb * 64, n0, (bf16_t*)(P.ws + WS_WB) + (size_t)n0 * DM + kb * 64, DM, scr, lane);
        else tr_item(P.w_o + (size_t)layer * DM * DM, DM, kb * 64, n0, (bf16_t*)(P.ws + WS_WO) + (size_t)n0 * DM + kb * 64, DM, scr, lane);
    }
}

__device__ __forceinline__ const float* x_row(const Params& P, int layer, int tok) {
    if (layer == 0) return tok < T_PROMPT ? P.xp + (size_t)tok * DM : P.xs + (size_t)(tok - T_PROMPT) * DM;
    return P.out + (size_t)tok * DM;
}

__device__ __forceinline__ void phase_rms(const Params& P, int layer, int tok0, int Tp, int gw, int NGW, int lane) {
    bf16_t* H = full_ptr(P, F_H) + (size_t)tok0 * DM;
    const float* g = P.norm_g + layer * DM;
    f32x4 gv[4];
#pragma unroll
    for (int j = 0; j < 4; ++j) gv[j] = *(const f32x4*)(g + 4 * lane + 256 * j);
    for (int lt = gw; lt < Tp; lt += NGW) {
        const float* xr = x_row(P, layer, tok0 + lt);
        f32x4 v[4]; float s = 0.f;
#pragma unroll
        for (int j = 0; j < 4; ++j) { v[j] = *(const f32x4*)(xr + 4 * lane + 256 * j); s += (v[j].x * v[j].x + v[j].y * v[j].y) + (v[j].z * v[j].z + v[j].w * v[j].w); }
        const float rstd = rsqrtf(wave_sum(s) * (1.f / DM) + EPS);
#pragma unroll
        for (int j = 0; j < 4; ++j) { u32x2 o; o.x = cvt_pk_bf16(v[j].x * rstd * gv[j].x, v[j].y * rstd * gv[j].y); o.y = cvt_pk_bf16(v[j].z * rstd * gv[j].z, v[j].w * rstd * gv[j].w);
            *(u32x2*)(H + (size_t)lt * DM + 4 * lane + 256 * j) = o; }
    }
}

__device__ __forceinline__ void phase_final(const Params& P, int gw, int NGW, int lane) {
    f32x4 gv[4];
#pragma unroll
    for (int j = 0; j < 4; ++j) gv[j] = *(const f32x4*)(P.final_g + 4 * lane + 256 * j);
    for (int t = gw; t < T_ALL; t += NGW) {
        float* xr = P.out + (size_t)t * DM;
        f32x4 v[4]; float s = 0.f;
#pragma unroll
        for (int j = 0; j < 4; ++j) { v[j] = *(const f32x4*)(xr + 4 * lane + 256 * j); s += (v[j].x * v[j].x + v[j].y * v[j].y) + (v[j].z * v[j].z + v[j].w * v[j].w); }
        const float rstd = rsqrtf(wave_sum(s) * (1.f / DM) + EPS);
#pragma unroll
        for (int j = 0; j < 4; ++j) *(f32x4*)(xr + 4 * lane + 256 * j) = v[j] * rstd * gv[j];
    }
}

__device__ __forceinline__ void unpack8(const u32x4 w, float* o) {
    o[0] = bf_lo(w.x); o[1] = bf_hi(w.x); o[2] = bf_lo(w.y); o[3] = bf_hi(w.y); o[4] = bf_lo(w.z); o[5] = bf_hi(w.z); o[6] = bf_lo(w.w); o[7] = bf_hi(w.w);
}
__device__ __forceinline__ u32x4 pack8(const float* o) { u32x4 w; w.x = cvt_pk_bf16(o[0], o[1]); w.y = cvt_pk_bf16(o[2], o[3]); w.z = cvt_pk_bf16(o[4], o[5]); w.w = cvt_pk_bf16(o[6], o[7]); return w; }

__device__ __forceinline__ void phase_combine(const Params& P, int layer, int tok0, int Tp, int gw, int NGW, int lane) {
    const bf16_t* OF = full_ptr(P, F_QF) + (size_t)tok0 * DM; const bf16_t* OB = full_ptr(P, F_QB) + (size_t)tok0 * DM;
    bf16_t* SZ = pass_ptr(P, S_SZA); const bf16_t* U = pass_ptr(P, S_U); bf16_t* Mm = pass_ptr(P, S_M);
    const int c0 = lane * 16;
    float hg[16], w0[16], w1[16], w2[16], cb[16];
#pragma unroll
    for (int j = 0; j < 16; ++j) { hg[j] = P.hnorm_g[layer * DM + c0 + j]; w0[j] = P.conv_w[(layer * 3 + 0) * DM + c0 + j]; w1[j] = P.conv_w[(layer * 3 + 1) * DM + c0 + j];
        w2[j] = P.conv_w[(layer * 3 + 2) * DM + c0 + j]; cb[j] = P.conv_b[layer * DM + c0 + j]; }
    for (int lt = gw; lt < Tp; lt += NGW) {
        const int tok = tok0 + lt;
        const int L = tok < T_PROMPT ? 8192 : 4096; const int pos = tok & (L - 1);
        const size_t ro = (size_t)lt * DM + c0;
        float a[16], b[16], z[16];
        unpack8(*(const u32x4*)(OF + ro), a); unpack8(*(const u32x4*)(OF + ro + 8), a + 8);
        unpack8(*(const u32x4*)(OB + ro), b); unpack8(*(const u32x4*)(OB + ro + 8), b + 8);
        unpack8(*(const u32x4*)(SZ + ro), z); unpack8(*(const u32x4*)(SZ + ro + 8), z + 8);
        float ss = 0.f;
#pragma unroll
        for (int j = 0; j < 16; ++j) { a[j] += b[j]; ss += a[j] * a[j]; }
        ss += __shfl_xor(ss, 1); ss += __shfl_xor(ss, 2); ss += __shfl_xor(ss, 4);
        const float rstd = rsqrtf(ss * (1.f / 128.f) + EPS);
#pragma unroll
        for (int j = 0; j < 16; ++j) a[j] = a[j] * rstd * hg[j] * z[j];
        *(u32x4*)(SZ + ro) = pack8(a); *(u32x4*)(SZ + ro + 8) = pack8(a + 8);
        float up[16], uc[16], un[16], mm[16];
        unpack8(*(const u32x4*)(U + ro), uc); unpack8(*(const u32x4*)(U + ro + 8), uc + 8);
        unpack8(*(const u32x4*)(Mm + ro), mm); unpack8(*(const u32x4*)(Mm + ro + 8), mm + 8);
        if (pos > 0) { unpack8(*(const u32x4*)(U + ro - DM), up); unpack8(*(const u32x4*)(U + ro - DM + 8), up + 8); }
        else {
#pragma unroll
            for (int j = 0; j < 16; ++j) up[j] = 0.f; }
        if (pos < L - 1) { unpack8(*(const u32x4*)(U + ro + DM), un); unpack8(*(const u32x4*)(U + ro + DM + 8), un + 8); }
        else {
#pragma unroll
            for (int j = 0; j < 16; ++j) un[j] = 0.f; }
#pragma unroll
        for (int j = 0; j < 16; ++j) mm[j] = mm[j] * (w0[j] * up[j] + w1[j] * uc[j] + w2[j] * un[j] + cb[j]);
        *(u32x4*)(Mm + ro) = pack8(mm); *(u32x4*)(Mm + ro + 8) = pack8(mm + 8);
    }
}
#define MFMA16(a, b, c) __builtin_amdgcn_mfma_f32_16x16x32_bf16((a), (b), (c), 0, 0, 0)

constexpr int SC_E01 = 0, SC_QT = 512, SC_KD = 17920, SC_KO = 35328, SC_QG = 44032, SC_KCT = 52736, SC_VT = 71296, SC_P = 89856, SC_END = 99072;
constexpr int RS = 272;
constexpr int TS = 144;

__device__ __forceinline__ void scan_item(const Params& P, LAS unsigned char* lds, int base, int L, int head, int dir, int tid) {
    const int wave = __builtin_amdgcn_readfirstlane(tid >> 6), lane = tid & 63, r16 = lane & 15, q4 = lane >> 4;
    const int rp = tid >> 4, cs = tid & 15, c0 = cs * 8;
    const int pa = cs & 3, plo = (cs >> 2) * 32 + 16 * (pa & 1) + 4 * (pa >> 1);
    bf16_t* QD = full_ptr(P, dir ? F_QB : F_QF); const bf16_t* KDg = full_ptr(P, dir ? F_KB : F_KF); const bf16_t* I = full_ptr(P, F_I);
    const bf16_t* ET = (const bf16_t*)(P.ws + WS_ET) + (size_t)dir * NCHUNK * 2 * DM + head * 128 + c0;
    const int nch = L >> 6, chunk0 = base >> 6;
    const int tr0 = dir ? 63 - 2 * rp : 2 * rp, tr1 = dir ? 62 - 2 * rp : 2 * rp + 1;
    LAS float* E01 = (LAS float*)(lds + SC_E01);
    f32x4 S[8];
#pragma unroll
    for (int i = 0; i < 8; ++i) S[i] = (f32x4){0.f, 0.f, 0.f, 0.f};
    u32x4 rq[2], rk[2], rv[2], re0, re1;
    {   const int ci = dir ? nch - 1 : 0; const size_t gb = (size_t)(base + ci * 64) * DM + head * 128 + c0;
        rq[0] = *(const u32x4*)(QD + gb + (size_t)tr0 * DM); rq[1] = *(const u32x4*)(QD + gb + (size_t)tr1 * DM);
        rk[0] = *(const u32x4*)(KDg + gb + (size_t)tr0 * DM); rk[1] = *(const u32x4*)(KDg + gb + (size_t)tr1 * DM);
        rv[0] = *(const u32x4*)(I + gb + (size_t)tr0 * DM); rv[1] = *(const u32x4*)(I + gb + (size_t)tr1 * DM);
        const bf16_t* ep = ET + (size_t)(chunk0 + ci) * 2 * DM;
        re0 = *(const u32x4*)(ep); re1 = *(const u32x4*)(ep + DM); }
#pragma unroll 1
    for (int n = 0; n < nch; ++n) {
        const int ci = dir ? nch - 1 - n : n;
        const size_t gcur = (size_t)(base + ci * 64) * DM + head * 128 + c0;
        {   float e0[8], e1[8];
            unpack8(re0, e0); unpack8(re1, e1);
            const bool lo = rp < 16;
            unsigned kcp[8], vtp[8];
            float kc0[8], v0[8];
#pragma unroll
            for (int r = 0; r < 2; ++r) {
                const int row = 2 * rp + r;
                float qv[8], kv[8], vv[8];
                unpack8(rq[r], qv); unpack8(rk[r], kv); unpack8(rv[r], vv);
                *(LAS u32x2*)(lds + SC_QT + row * RS + plo * 2) = (u32x2){rq[r].x, rq[r].y}; *(LAS u32x2*)(lds + SC_QT + row * RS + plo * 2 + 16) = (u32x2){rq[r].z, rq[r].w};
                *(LAS u32x2*)(lds + SC_KD + row * RS + plo * 2) = (u32x2){rk[r].x, rk[r].y}; *(LAS u32x2*)(lds + SC_KD + row * RS + plo * 2 + 16) = (u32x2){rk[r].z, rk[r].w};
                float ox[8], okc[8];
#pragma unroll
                for (int j = 0; j < 8; ++j) {
                    if (lo) { ox[j] = kv[j] * e0[j]; okc[j] = ox[j] * e1[j]; }
                    else { ox[j] = qv[j] * e0[j]; okc[j] = kv[j] * e1[j]; }
                }
                u32x2 w0, w1; w0.x = pkbf(ox[0], ox[1]); w0.y = pkbf(ox[2], ox[3]); w1.x = pkbf(ox[4], ox[5]); w1.y = pkbf(ox[6], ox[7]);
                if (lo) { *(LAS u32x2*)(lds + SC_KO + row * RS + plo * 2) = w0; *(LAS u32x2*)(lds + SC_KO + row * RS + plo * 2 + 16) = w1; }
                else { *(LAS u32x2*)(lds + SC_QG + (row - 32) * RS + plo * 2) = w0; *(LAS u32x2*)(lds + SC_QG + (row - 32) * RS + plo * 2 + 16) = w1; }
                if (r == 0) {
#pragma unroll
                    for (int j = 0; j < 8; ++j) { kc0[j] = okc[j]; v0[j] = vv[j]; }
                } else {
#pragma unroll
                    for (int j = 0; j < 8; ++j) { kcp[j] = pkbf(kc0[j], okc[j]); vtp[j] = pkbf(v0[j], vv[j]); }
                }
            }
#pragma unroll
            for (int j = 0; j < 8; ++j) {
                *(LAS unsigned*)(lds + SC_KCT + (c0 + j) * TS + (cs >> 1) * 16 + rp * 4) = kcp[j];
                *(LAS unsigned*)(lds + SC_VT + (c0 + j) * TS + (cs >> 1) * 16 + rp * 4) = vtp[j];
            }
            if (rp == 0) {
#pragma unroll
                for (int j = 0; j < 8; ++j) E01[c0 + j] = e0[j] * e1[j];
            }
        }
        if (n + 1 < nch) { const int cn = dir ? nch - 2 - n : n + 1; const size_t gb = (size_t)(base + cn * 64) * DM + head * 128 + c0;
            rq[0] = *(const u32x4*)(QD + gb + (size_t)tr0 * DM); rq[1] = *(const u32x4*)(QD + gb + (size_t)tr1 * DM);
            rk[0] = *(const u32x4*)(KDg + gb + (size_t)tr0 * DM); rk[1] = *(const u32x4*)(KDg + gb + (size_t)tr1 * DM);
            rv[0] = *(const u32x4*)(I + gb + (size_t)tr0 * DM); rv[1] = *(const u32x4*)(I + gb + (size_t)tr1 * DM);
            const bf16_t* ep = ET + (size_t)(chunk0 + cn) * 2 * DM;
            re0 = *(const u32x4*)(ep); re1 = *(const u32x4*)(ep + DM); }
        __syncthreads();
#pragma unroll
        for (int e = 0; e < 2; ++e) {
            const int ti = wave >> 1, sj = 2 * (wave & 1) + e;
            if (sj > ti) {
                if ((ti == 0 && sj == 1) || (ti == 2 && sj == 3)) {
#pragma unroll
                    for (int i = 0; i < 4; ++i) *(LAS bf16_t*)(lds + SC_P + (16 * ti + 4 * q4 + i) * TS + (16 * sj + r16) * 2) = 0;
                }
                continue;
            }
            const int kbase = ((ti >> 1) == (sj >> 1)) ? SC_KD : SC_KO;
            f32x4 acc = (f32x4){0.f, 0.f, 0.f, 0.f};
#pragma unroll
            for (int ks = 0; ks < 4; ++ks) {
                const bf16x8 a = *(const LAS bf16x8*)(lds + SC_QT + (16 * ti + r16) * RS + (32 * ks + 8 * q4) * 2);
                const bf16x8 b = *(const LAS bf16x8*)(lds + kbase + (16 * sj + r16) * RS + (32 * ks + 8 * q4) * 2);
                acc = MFMA16(a, b, acc);
            }
#pragma unroll
            for (int i = 0; i < 4; ++i) {
                float v = acc[i];
                if (ti == sj && r16 > 4 * q4 + i) v = 0.f;
                *(LAS bf16_t*)(lds + SC_P + (16 * ti + 4 * q4 + i) * TS + (16 * sj + r16) * 2) = (bf16_t)(pkbf(v, 0.f) & 0xffffu);
            }
        }
        __syncthreads();
        f32x4 o[4];
#pragma unroll
        for (int i = 0; i < 4; ++i) o[i] = (f32x4){0.f, 0.f, 0.f, 0.f};
#pragma unroll
        for (int ks = 0; ks < 4; ++ks) {
            u32x4 bw; bw.x = pkbf(S[2 * ks][0], S[2 * ks][1]); bw.y = pkbf(S[2 * ks][2], S[2 * ks][3]); bw.z = pkbf(S[2 * ks + 1][0], S[2 * ks + 1][1]); bw.w = pkbf(S[2 * ks + 1][2], S[2 * ks + 1][3]);
            const bf16x8 b = __builtin_bit_cast(bf16x8, bw);
#pragma unroll
            for (int ti = 0; ti < 4; ++ti) {
                const int abase = (ti < 2) ? SC_QT + (16 * ti + r16) * RS : SC_QG + (16 * (ti - 2) + r16) * RS;
                const bf16x8 aw = *(const LAS bf16x8*)(lds + abase + (32 * ks + 8 * q4) * 2);
                o[ti] = MFMA16(aw, b, o[ti]);
            }
        }
        bf16x8 vb[2];
#pragma unroll
        for (int ss = 0; ss < 2; ++ss) vb[ss] = *(const LAS bf16x8*)(lds + SC_VT + (16 * wave + r16) * TS + wave * 16 + (32 * ss + 8 * q4) * 2);
#pragma unroll
        for (int ti = 0; ti < 4; ++ti)
#pragma unroll
            for (int ss = 0; ss <= (ti >> 1); ++ss) {
                const bf16x8 a = *(const LAS bf16x8*)(lds + SC_P + (16 * ti + r16) * TS + (32 * ss + 8 * q4) * 2);
                o[ti] = MFMA16(a, vb[ss], o[ti]);
            }
#pragma unroll
        for (int kt = 0; kt < 8; ++kt) {
            const f32x4 e4 = *(const LAS f32x4*)(E01 + 16 * kt + 4 * q4);
            S[kt] = S[kt] * e4;
#pragma unroll
            for (int ss = 0; ss < 2; ++ss) {
                const bf16x8 a = *(const LAS bf16x8*)(lds + SC_KCT + (16 * kt + r16) * TS + kt * 16 + (32 * ss + 8 * q4) * 2);
                S[kt] = MFMA16(a, vb[ss], S[kt]);
            }
        }
#pragma unroll
        for (int ti = 0; ti < 4; ++ti)
#pragma unroll
            for (int i = 0; i < 4; ++i) *(LAS bf16_t*)(lds + SC_KD + (16 * ti + 4 * q4 + i) * RS + (16 * wave + r16) * 2) = (bf16_t)(pkbf(o[ti][i], 0.f) & 0xffffu);
        __syncthreads();
        {   const u32x4 w0 = *(const LAS u32x4*)(lds + SC_KD + (2 * rp) * RS + c0 * 2), w1 = *(const LAS u32x4*)(lds + SC_KD + (2 * rp + 1) * RS + c0 * 2);
            *(u32x4*)(QD + gcur + (size_t)tr0 * DM) = w0; *(u32x4*)(QD + gcur + (size_t)tr1 * DM) = w1; }
    }
    __syncthreads();
}

__device__ __forceinline__ void scan_one(const Params& P, LAS unsigned char* lds, int it, int tid) {
    const int seq = it >> 4, head = (it >> 1) & 7, dir = it & 1;
    int base, L;
    if (seq < 2) { base = seq * 8192; L = 8192; } else { base = T_PROMPT + (seq - 2) * 4096; L = 4096; }
    scan_item(P, lds, base, L, head, dir, tid);
}
__device__ __forceinline__ void phase_scan(const Params& P, LAS unsigned char* lds, int tid) {
    const int b = blockIdx.x, G = gridDim.x;
    if (G >= 256) {
        if (b < 256) scan_one(P, lds, b, tid);
        if (b >= 32 && b < 64) scan_one(P, lds, 256 + (b - 32), tid);
    } else {
        for (int it = b; it < 288; it += G) scan_one(P, lds, it, tid);
    }
}
#define XB_TMO      128
#define XB_XCNT(j)  (256  + 64 * (j))
#define XB_XSUB(j)  (1280 + 64 * (j))
#define XB_XGEN(j)  (2304 + 64 * (j))
#define XB_TOP      3328
#define XB_TOPGEN   3392
#define XCD_BAR_WORDS 3456
#define XB_SPIN_CAP (1u << 22)
__device__ __forceinline__ unsigned xb_ld(unsigned* p)              { return __hip_atomic_load(p, __ATOMIC_RELAXED, __HIP_MEMORY_SCOPE_AGENT); }
__device__ __forceinline__ unsigned xb_add(unsigned* p, unsigned v) { return __hip_atomic_fetch_add(p, v, __ATOMIC_RELAXED, __HIP_MEMORY_SCOPE_AGENT); }
__device__ __forceinline__ unsigned xb_xcc_id() { return (unsigned)__builtin_amdgcn_s_getreg((3 << 11) | 20) & 0xFu; }
#define XB_SPIN(cond, bar) do { unsigned _sp = 0; while (cond) { __builtin_amdgcn_s_sleep(1); \
    if ((++_sp & 255u) == 0u) { if (xb_ld(&(bar)[XB_TMO])) break; if (_sp > XB_SPIN_CAP) { atomicAdd(&(bar)[XB_TMO], 1u); break; } } } } while (0)
struct XcdBarrier { unsigned* bar; unsigned x; volatile LAS unsigned* st; };
__device__ __forceinline__ void xcd_barrier_complete(unsigned* bar, unsigned x, unsigned& nloc, unsigned& nx) {
    const unsigned G = gridDim.x * gridDim.y * gridDim.z;
    unsigned sum, cnt, mine, sp = 0u;
    for (;;) {
        sum = 0u; cnt = 0u; mine = 0u;
#pragma unroll
        for (unsigned j = 0; j < 16; ++j) { const unsigned c = xb_ld(&bar[XB_XCNT(j)]); sum += c; cnt += (c > 0u) ? 1u : 0u; mine = (j == x) ? c : mine; }
        if (sum == G) break;
        __builtin_amdgcn_s_sleep(1);
        if ((++sp & 255u) == 0u) { if (xb_ld(&bar[XB_TMO])) break; if (sp > XB_SPIN_CAP) { atomicAdd(&bar[XB_TMO], 1u); break; } }
    }
    nloc = mine > 0u ? mine : 1u; nx = cnt > 0u ? cnt : 1u;
}
__device__ __forceinline__ void xcd_barrier(const XcdBarrier& b) {
    asm volatile("s_waitcnt vmcnt(0)" ::: "memory");
    __syncthreads();
    if (threadIdx.x == 0) {
        unsigned* bar = b.bar;
        __builtin_amdgcn_s_waitcnt(0);
        unsigned nloc = b.st[0], nx = b.st[1];
        if (nloc == 0u) { xcd_barrier_complete(bar, b.x, nloc, nx); b.st[0] = nloc; b.st[1] = nx; }
        const unsigned old = xb_add(&bar[XB_XSUB(b.x)], 1u);
        const unsigned gen = old / nloc;
        if (old + 1u == (gen + 1u) * nloc) {
            __builtin_amdgcn_fence(__ATOMIC_RELEASE, "agent");
            asm volatile("s_waitcnt vmcnt(0)" ::: "memory");
            const unsigned og = xb_add(&bar[XB_TOP], 1u);
            const unsigned tg = og / nx;
            if (og + 1u == (tg + 1u) * nx) xb_add(&bar[XB_TOPGEN], 1u);
            else XB_SPIN(xb_ld(&bar[XB_TOPGEN]) == tg, bar);
            __builtin_amdgcn_fence(__ATOMIC_ACQUIRE, "agent");
            xb_add(&bar[XB_XGEN(b.x)], 1u);
            asm volatile("s_waitcnt vmcnt(0)" ::: "memory");
        } else {
            XB_SPIN(xb_ld(&bar[XB_XGEN(b.x)]) == gen, bar);
            __builtin_amdgcn_fence(__ATOMIC_ACQUIRE, "agent");
            asm volatile("s_waitcnt vmcnt(0)" ::: "memory");
        }
    }
    __syncthreads();
}

typedef const __attribute__((address_space(4))) Params* KParams;
__device__ __forceinline__ Params getP(KParams kp) { asm volatile("" : "+s"(kp)); const Params* gp = (const Params*)kp; return *gp; }
__device__ __forceinline__ int opq(int x) { asm volatile("" : "+s"(x)); return x; }
#define PH(call) do { const Params P = getP(kp); int t_ = threadIdx.x; asm volatile("" : "+v"(t_)); const int tid = t_, wave = tid >> 6, lane = tid & 63, gw = blockIdx.x * 8 + wave; (void)lane; (void)gw; call; } while (0)
#define GSYNC() do { const Params P = getP(kp); XcdBarrier xb_; xb_.bar = (unsigned*)(P.ws + WS_BAR); xb_.x = xb_xcc_id(); xb_.st = (volatile LAS unsigned*)(lds + BAR_LDS); xcd_barrier(xb_); } while (0)
__global__ __launch_bounds__(512, 2) void mega_fwd(Params Parg) {
    KParams kp = (KParams)__builtin_amdgcn_kernarg_segment_ptr();
    extern __shared__ __attribute__((aligned(16))) unsigned char shm[];
    LAS unsigned char* lds = (LAS unsigned char*)shm;
    cg::grid_group grid = cg::this_grid();
    const int G = gridDim.x, NGW = G * 8;
    if (threadIdx.x == 0) { ((volatile LAS unsigned*)(lds + BAR_LDS))[0] = 0u; ((volatile LAS unsigned*)(lds + BAR_LDS))[1] = 0u;
        const Params P = getP(kp); (void)xb_add(&((unsigned*)(P.ws + WS_BAR))[XB_XCNT(xb_xcc_id())], 1u); }
    __syncthreads();

#pragma unroll 1
    for (int layer = 0; layer < 2; ++layer) {
        PH(phase_prep(P, lds, layer, gw, NGW, wave, lane); phase_rms(P, layer, 0, T_ALL, gw, NGW, lane));
        if (layer == 0) grid.sync(); else GSYNC();
        {   const Params P = getP(kp); pg8::Gemm g; g.A = full_ptr(P, F_H); g.Bt = (const bf16_t*)(P.ws + WS_WIN); g.A2 = g.A; g.Bt2 = g.Bt; g.M = opq(T_ALL); g.N = opq(NP1); g.K = opq(DM);
            pg8::PanelGroupOrder S; S.init(g.M, opq(G), opq(blockIdx.x));
            EpiPart1 E; E.full = full_ptr(P, 0); E.et = (bf16_t*)(P.ws + WS_ET); E.lbf = P.lb_fwd; E.lbb = P.lb_bwd; E.layer = layer;
            pg8::gemm_phase(lds, g, S, E); }
        GSYNC();
        PH(phase_scan(P, lds, tid));
        GSYNC();
#pragma unroll 1
        for (int pass = 0; pass < NPASS; ++pass) {
            const int tok0 = pass == 0 ? PASS_TOK0 : PASS_TOK1;
            const int Tp = pass == 0 ? (PASS_TOK1 - PASS_TOK0) : (T_ALL - PASS_TOK1);
            {   const Params P = getP(kp); pg8::Gemm g; g.A = full_ptr(P, F_H) + (size_t)tok0 * DM; g.Bt = (const bf16_t*)(P.ws + WS_WIN) + (size_t)NP1 * DM; g.A2 = g.A; g.Bt2 = g.Bt; g.M = opq(Tp); g.N = opq(NP2); g.K = opq(DM);
                pg8::StaticOrder S; S.init(g.M, g.N, opq(G), opq(blockIdx.x));
                EpiPart2 E; E.arr = pass_ptr(P, 0);
                pg8::gemm_phase(lds, g, S, E); }
            GSYNC();
            PH(phase_combine(P, layer, tok0, Tp, gw, NGW, lane));
            GSYNC();
            {   const Params P = getP(kp); pg8::Gemm g; g.A = pass_ptr(P, S_SZA); g.A2 = pass_ptr(P, S_M); g.Bt = (const bf16_t*)(P.ws + WS_WA); g.Bt2 = (const bf16_t*)(P.ws + WS_WB); g.M = opq(Tp); g.N = opq(DM); g.K = opq(DM);
                pg8::SplitOrder S; S.init(g.M, g.N, opq(G), opq(blockIdx.x));
                EpiMerge E; E.sga = pass_ptr(P, S_SGA); E.sgb = pass_ptr(P, S_SGB); E.outp = pass_ptr(P, S_U);
                pg8::gemm_phase(lds, g, S, E); }
            GSYNC();
            {   const Params P = getP(kp); pg8::Gemm g; g.A = pass_ptr(P, S_U); g.Bt = (const bf16_t*)(P.ws + WS_WO); g.A2 = g.A; g.Bt2 = g.Bt; g.M = opq(Tp); g.N = opq(DM); g.K = opq(DM);
                pg8::StaticOrder S; S.init(g.M, g.N, opq(G), opq(blockIdx.x));
                EpiOut E; E.xp = P.xp; E.xs = P.xs; E.out = P.out; E.layer = layer; E.tok0 = tok0;
                pg8::gemm_phase(lds, g, S, E); }
            GSYNC();
        }
    }
    PH(phase_final(P, gw, NGW, lane));
}

extern "C" void kernel_launch(void* const* d_in, const int* in_sizes, int n_in, void* d_out, int out_size, void* d_ws, size_t ws_size, hipStream_t stream) {
    static int grid_blocks = 0;
    if (grid_blocks == 0) {
        if (n_in != 13 || out_size != T_ALL * DM || ws_size < WS_TOTAL) { fprintf(stderr, "kernel_launch: unexpected shapes (n_in %d out %d ws %zu need %zu)\n", n_in, out_size, ws_size, (size_t)WS_END); grid_blocks = -1; return; }
        int dev = 0, cus = 0, per_cu = 0;
        hipGetDevice(&dev);
        hipDeviceGetAttribute(&cus, hipDeviceAttributeMultiprocessorCount, dev);
        if (hipFuncSetAttribute((const void*)mega_fwd, hipFuncAttributeMaxDynamicSharedMemorySize, LDS_BYTES) != hipSuccess) { fprintf(stderr, "hipFuncSetAttribute failed\n"); grid_blocks = -1; return; }
        hipOccupancyMaxActiveBlocksPerMultiprocessor(&per_cu, (const void*)mega_fwd, 512, LDS_BYTES);
        if (per_cu < 1) per_cu = 1;
        grid_blocks = cus * per_cu;
        (void)hipGetLastError();
    }
    if (grid_blocks < 0) return;
    Params p{};
    p.xp = (const float*)d_in[0]; p.xs = (const float*)d_in[1]; p.norm_g = (const float*)d_in[2]; p.w_in = (const float*)d_in[3];
    p.lb_fwd = (const float*)d_in[4]; p.lb_bwd = (const float*)d_in[5]; p.hnorm_g = (const float*)d_in[6]; p.conv_w = (const float*)d_in[7];
    p.conv_b = (const float*)d_in[8]; p.w_a = (const float*)d_in[9]; p.w_b = (const float*)d_in[10]; p.w_o = (const float*)d_in[11]; p.final_g = (const float*)d_in[12];
    p.out = (float*)d_out; p.ws = (unsigned char*)d_ws;
    if (hipMemsetAsync((char*)d_ws + WS_BAR, 0, XCD_BAR_WORDS * 4, stream) != hipSuccess) { fprintf(stderr, "memset of barrier words failed\n"); return; }
    void* args[] = {&p};
    hipError_t e = hipLaunchCooperativeKernel((const void*)mega_fwd, dim3(grid_blocks), dim3(512), args, LDS_BYTES, stream);
    if (e != hipSuccess) fprintf(stderr, "cooperative launch failed: %s (grid %d)\n", hipGetErrorString(e), grid_blocks);
}
```
